# Optimizing an MI355X kernel written in HIP

```python
import jax, jax.numpy as jnp
from jax import lax
import numpy as np


D_MODEL = 4096
BATCH = 1
SEQ = 8192
DEPTH = 1

CHUNK = 64
Q_BLOCK = 128
ML_HEADS = 8
ML_V_DIM = 256
ML_QK_DIM = 128
ML_WIDTH = ML_HEADS * ML_V_DIM
ML_QK_WIDTH = ML_HEADS * ML_QK_DIM
SB_HEADS = 16
SB_HEAD_DIM = 128
SB_WIDTH = SB_HEADS * SB_HEAD_DIM
CONV_WIDTH = 4
D_FF = 11008
N_BRANCH = 2
EPS = 1e-6
IN_SIZES = (ML_QK_WIDTH, ML_QK_WIDTH, ML_WIDTH, ML_WIDTH, ML_HEADS, ML_HEADS,
            SB_WIDTH, SB_WIDTH, SB_WIDTH, D_MODEL, D_MODEL)
D_IN = 2 * ML_QK_WIDTH + 2 * ML_WIDTH + 2 * ML_HEADS + 3 * SB_WIDTH + N_BRANCH * D_MODEL

kernel_name = 'hybrid_mlstm_stickbreak_macaron'


def rmsnorm(x, g):
    xf = x.astype(jnp.float32)
    y = xf * lax.rsqrt(jnp.mean(xf * xf, axis=-1, keepdims=True) + EPS)
    return (y * g.astype(jnp.float32)).astype(x.dtype)


def swiglu(h, w1, w3, w2):
    return (jax.nn.silu(h @ w1) * (h @ w3)) @ w2


def split_cols(p, sizes):
    offs = []
    acc = 0
    for s in sizes[:-1]:
        acc += s
        offs.append(acc)
    return jnp.split(p, offs, axis=-1)


def causal_depthwise_conv(x, w):
    k = w.shape[0]
    return lax.conv_general_dilated(
        x, w[:, None, :].astype(x.dtype), window_strides=(1,), padding=[(k - 1, 0)],
        dimension_numbers=('NWC', 'WIO', 'NWC'), feature_group_count=x.shape[-1])


def mlstm(q, k, v, log_i, log_f):
    B, S, H, dk = q.shape
    dv = v.shape[-1]
    nc = S // CHUNK
    k = k * (dk ** -0.5)

    def chunks(a):
        a = a.reshape((B, nc, CHUNK) + a.shape[2:])
        return jnp.moveaxis(jnp.moveaxis(a, 1, 0), 3, 2)

    tril = jnp.tril(jnp.ones((CHUNK, CHUNK), dtype=bool))

    def step(carry, inp):
        C, n, m = carry
        qc, kc, vc, ic, fc = inp
        b = jnp.cumsum(fc, axis=-1)
        log_d = jnp.where(tril, b[..., :, None] - b[..., None, :] + ic[..., None, :], -jnp.inf)
        m_inter = b + m[..., None]
        m_t = jnp.maximum(m_inter, jnp.max(log_d, axis=-1))
        w = jnp.einsum('bhtd,bhsd->bhts', qc, kc) * jnp.exp(log_d - m_t[..., None])
        decay = jnp.exp(m_inter - m_t)
        num = (decay[..., None] * jnp.einsum('bhtd,bhdv->bhtv', qc, C)
               + jnp.einsum('bhts,bhsv->bhtv', w, vc))
        den = decay * jnp.einsum('bhtd,bhd->bht', qc, n) + jnp.sum(w, axis=-1)
        h = num / jnp.maximum(jnp.abs(den), jnp.exp(-m_t))[..., None]
        b_last = b[..., -1]
        a = b_last[..., None] - b + ic
        m_new = jnp.maximum(b_last + m, jnp.max(a, axis=-1))
        carry_scale = jnp.exp(b_last + m - m_new)
        src = jnp.exp(a - m_new[..., None])
        C = carry_scale[..., None, None] * C + jnp.einsum('bhs,bhsd,bhsv->bhdv', src, kc, vc)
        n = carry_scale[..., None] * n + jnp.einsum('bhs,bhsd->bhd', src, kc)
        return (C, n, m_new), h

    init = (jnp.zeros((B, H, dk, dv), q.dtype), jnp.zeros((B, H, dk), q.dtype),
            jnp.zeros((B, H), q.dtype))
    _, hs = lax.scan(step, init, (chunks(q), chunks(k), chunks(v), chunks(log_i), chunks(log_f)))
    hs = jnp.moveaxis(jnp.moveaxis(hs, 2, 3), 0, 1)
    return hs.reshape(B, S, H, dv)


def stick_breaking(q, k, v):
    B, S, H, d = q.shape
    nb = S // Q_BLOCK
    q = jnp.transpose(q, (0, 2, 1, 3)) * (d ** -0.5)
    k = jnp.transpose(k, (0, 2, 1, 3))
    v = jnp.transpose(v, (0, 2, 1, 3))
    q_blocks = jnp.transpose(q.reshape(B, H, nb, Q_BLOCK, d), (2, 0, 1, 3, 4))
    starts = jnp.arange(nb, dtype=jnp.int32) * Q_BLOCK
    key_pos = jnp.arange(S, dtype=jnp.int32)

    def block(args):
        qb, start = args
        z = jnp.einsum('bhqd,bhkd->bhqk', qb, k)
        qpos = start + jnp.arange(Q_BLOCK, dtype=jnp.int32)
        strict = key_pos[None, :] < qpos[:, None]
        log_beta = jax.nn.log_sigmoid(z)
        log_rest = jnp.where(strict, jax.nn.log_sigmoid(-z), 0.0)
        after = lax.cumsum(log_rest, axis=3, reverse=True) - log_rest
        weights = jnp.where(strict, jnp.exp(log_beta + after), 0.0)
        return jnp.einsum('bhqk,bhkd->bhqd', weights, v)

    out = lax.map(block, (q_blocks, starts))
    return jnp.transpose(out, (1, 0, 3, 2, 4)).reshape(B, S, H, d)


def setup_inputs(seed: int = 0) -> dict:
    key = jax.random.key(seed)
    ks = jax.random.split(key, 20)
    f32 = jnp.float32

    def w(k, shape, fan_in):
        return jax.random.normal(k, shape, f32) * (fan_in ** -0.5)

    def gain(k, shape):
        return 1.0 + 0.01 * jax.random.normal(k, shape, f32)

    return {
        'x': jax.random.normal(ks[0], (BATCH, SEQ, D_MODEL), f32),
        'g_ffn1': gain(ks[1], (DEPTH, D_MODEL)),
        'w1_ffn1': w(ks[2], (DEPTH, D_MODEL, D_FF), D_MODEL),
        'w3_ffn1': w(ks[3], (DEPTH, D_MODEL, D_FF), D_MODEL),
        'w2_ffn1': w(ks[4], (DEPTH, D_FF, D_MODEL), D_FF),
        'g_mix': gain(ks[5], (DEPTH, D_MODEL)),
        'w_in': w(ks[6], (DEPTH, D_MODEL, D_IN), D_MODEL),
        'conv_qk': w(ks[7], (DEPTH, CONV_WIDTH, 2 * ML_QK_WIDTH), CONV_WIDTH),
        'b_igate': 0.1 * jax.random.normal(ks[8], (DEPTH, ML_HEADS), f32),
        'b_fgate': 3.0 + 0.5 * jax.random.normal(ks[9], (DEPTH, ML_HEADS), f32),
        'g_mlstm_out': gain(ks[10], (DEPTH, ML_WIDTH)),
        'w_proj_a': w(ks[11], (DEPTH, ML_WIDTH, D_MODEL), ML_WIDTH),
        'w_proj_b': w(ks[12], (DEPTH, SB_WIDTH, D_MODEL), SB_WIDTH),
        'w_out': w(ks[13], (DEPTH, D_MODEL, D_MODEL), D_MODEL),
        'g_ffn2': gain(ks[14], (DEPTH, D_MODEL)),
        'w1_ffn2': w(ks[15], (DEPTH, D_MODEL, D_FF), D_MODEL),
        'w3_ffn2': w(ks[16], (DEPTH, D_MODEL, D_FF), D_MODEL),
        'w2_ffn2': w(ks[17], (DEPTH, D_FF, D_MODEL), D_FF),
        'g_final': gain(ks[18], (D_MODEL,)),
    }


def reference(x, g_ffn1, w1_ffn1, w3_ffn1, w2_ffn1, g_mix, w_in, conv_qk, b_igate, b_fgate,
              g_mlstm_out, w_proj_a, w_proj_b, w_out, g_ffn2, w1_ffn2, w3_ffn2, w2_ffn2, g_final):
    B, S, _ = x.shape
    f32 = jnp.float32
    for l in range(DEPTH):
        x = x + 0.5 * swiglu(rmsnorm(x, g_ffn1[l]), w1_ffn1[l], w3_ffn1[l], w2_ffn1[l])

        h = rmsnorm(x, g_mix[l])
        p = h @ w_in[l]
        mq, mk, mv, mo, mi, mf, sq, sk, sv, ga, gb = split_cols(p, IN_SIZES)

        qk = jax.nn.silu(causal_depthwise_conv(jnp.concatenate([mq, mk], axis=-1), conv_qk[l]))
        mq, mk = jnp.split(qk.astype(f32), 2, axis=-1)
        log_i = mi.astype(f32) + b_igate[l].astype(f32)
        log_f = jax.nn.log_sigmoid(mf.astype(f32) + b_fgate[l].astype(f32))
        ya = mlstm(mq.reshape(B, S, ML_HEADS, ML_QK_DIM), mk.reshape(B, S, ML_HEADS, ML_QK_DIM),
                   mv.astype(f32).reshape(B, S, ML_HEADS, ML_V_DIM), log_i, log_f)
        ya = ya * lax.rsqrt(jnp.mean(ya * ya, axis=-1, keepdims=True) + EPS)
        ya = ya * g_mlstm_out[l].astype(f32).reshape(ML_HEADS, ML_V_DIM)
        ya = (ya.reshape(B, S, ML_WIDTH) * jax.nn.sigmoid(mo.astype(f32))).astype(x.dtype)

        yb = stick_breaking(sq.astype(f32).reshape(B, S, SB_HEADS, SB_HEAD_DIM),
                            sk.astype(f32).reshape(B, S, SB_HEADS, SB_HEAD_DIM),
                            sv.astype(f32).reshape(B, S, SB_HEADS, SB_HEAD_DIM))
        yb = yb.reshape(B, S, SB_WIDTH).astype(x.dtype)

        merged = jax.nn.sigmoid(ga) * (ya @ w_proj_a[l]) + jax.nn.sigmoid(gb) * (yb @ w_proj_b[l])
        x = x + merged @ w_out[l]

        x = x + 0.5 * swiglu(rmsnorm(x, g_ffn2[l]), w1_ffn2[l], w3_ffn2[l], w2_ffn2[l])
    return rmsnorm(x, g_final)
```

```cpp
#include <hip/hip_runtime.h>
#include <cstdio>
#include <cstdint>

#define LAS __attribute__((address_space(3)))
typedef unsigned short bf16;
typedef short bf16x8 __attribute__((ext_vector_type(8)));
typedef short s16x4 __attribute__((ext_vector_type(4)));
typedef float f32x4 __attribute__((ext_vector_type(4)));
typedef float f32x2 __attribute__((ext_vector_type(2)));
typedef float f32x16 __attribute__((ext_vector_type(16)));
typedef unsigned u32x4 __attribute__((ext_vector_type(4)));
typedef unsigned u32x2 __attribute__((ext_vector_type(2)));
typedef __bf16 bf16x2_t __attribute__((ext_vector_type(2)));

constexpr int M = 8192, D = 4096, FF = 11008, NP = 20480, DIN = 20496;
constexpr int NWAVES = 8, NTHR = 512;
constexpr int MLH = 8, DK = 128, DV = 256, SBH = 16, HD = 128, CH = 64, NCH = M / CH;
constexpr int PC_MQ = 0, PC_MK = 1024, PC_MV = 2048, PC_MO = 4096, PC_SQ = 6144, PC_SK = 8192, PC_SV = 10240, PC_GA = 12288, PC_GB = 16384;
constexpr float RMS_EPS = 1e-6f;

constexpr size_t MiB = 1u << 20;
constexpr size_t WS_CTL = 0, CTL_ZERO_BYTES = 1 * MiB;
constexpr size_t WS_GATE = 1 * MiB;
constexpr size_t WS_WG = 1 * MiB + 512 * 1024;
constexpr size_t WS_SC = 2 * MiB;
constexpr size_t WS_MS = 2 * MiB + 64 * 1024;
constexpr size_t WS_NL = 3 * MiB;
constexpr size_t WS_NS = 4 * MiB;
constexpr size_t WS_QC = 8 * MiB, WS_KC = 24 * MiB;
constexpr size_t WS_W13_1 = 40 * MiB, WS_W2_1 = 212 * MiB, WS_W13_2 = 298 * MiB, WS_W2_2 = 470 * MiB;
constexpr size_t WS_WIN = 556 * MiB, WS_WPA = 716 * MiB, WS_WPB = 732 * MiB, WS_WOUT = 748 * MiB;
constexpr size_t WS_H = 780 * MiB;
constexpr size_t WS_U = 844 * MiB;
constexpr size_t WS_X1 = 1016 * MiB;
constexpr size_t WS_XB = WS_X1;
constexpr size_t WS_P = 1144 * MiB;
constexpr size_t WS_YA = 1464 * MiB, WS_YB = 1496 * MiB;
constexpr size_t WS_END = 1528 * MiB;
constexpr int CW_BAR = 4096;
constexpr size_t CTL_SSQ = 65536;
constexpr size_t WS_X3 = WS_P;
constexpr size_t WS_XB2 = WS_YA;

__host__ __device__ __forceinline__ size_t blk(int r, int k, int K) { return (((size_t)((r >> 8) * (K >> 6) + (k >> 6))) << 14) + (size_t)(((r & 255) << 6) + (k & 63)); }

__device__ __forceinline__ float bf2f(unsigned short b) { return __uint_as_float(((unsigned)b) << 16); }
__device__ __forceinline__ float bflo(unsigned w) { return __uint_as_float(w << 16); }
__device__ __forceinline__ float bfhi(unsigned w) { return __uint_as_float(w & 0xffff0000u); }
__device__ __forceinline__ unsigned pk2(float lo, float hi) { f32x2 v = {lo, hi}; bf16x2_t b = __builtin_convertvector(v, bf16x2_t); return __builtin_bit_cast(unsigned, b); }
__device__ __forceinline__ float fsigmoid(float x) { return __builtin_amdgcn_rcpf(1.0f + __expf(-x)); }
__device__ __forceinline__ float fsilu(float x) { return x * fsigmoid(x); }
__device__ __forceinline__ float wave_sum(float v) {
#pragma unroll
    for (int o = 1; o < 64; o <<= 1) v += __shfl_xor(v, o);
    return v;
}
__device__ __forceinline__ float wave_max(float v) {
#pragma unroll
    for (int o = 1; o < 64; o <<= 1) v = fmaxf(v, __shfl_xor(v, o));
    return v;
}
__device__ __forceinline__ int crow(int r, int hi) { return (r & 3) + 8 * (r >> 2) + 4 * hi; }
typedef short v4i16_t __attribute__((ext_vector_type(4)));
__device__ __forceinline__ s16x4 ds_tr(LAS const unsigned char* p) { return __builtin_bit_cast(s16x4, __builtin_amdgcn_ds_read_tr16_b64_v4i16((LAS v4i16_t*)p)); }
__device__ __forceinline__ bf16x8 cat8(s16x4 lo, s16x4 hi) { return (bf16x8){lo[0], lo[1], lo[2], lo[3], hi[0], hi[1], hi[2], hi[3]}; }
__device__ __forceinline__ bf16x8 pack8(float a0, float a1, float a2, float a3, float a4, float a5, float a6, float a7) {
    u32x4 p; p.x = pk2(a0, a1); p.y = pk2(a2, a3); p.z = pk2(a4, a5); p.w = pk2(a6, a7); return __builtin_bit_cast(bf16x8, p);
}
#define MFMA32(a, b, c) __builtin_amdgcn_mfma_f32_32x32x16_bf16((a), (b), (c), 0, 0, 0)
#define MK_N_LAUNCHES 1
#define MK_SIDE_BY_SIDE 2
#ifndef PG_KREV
#define PG_KREV 1
#endif

namespace pg8 {
#define PG8_LAS __attribute__((address_space(3)))
typedef unsigned short bf16_t;
constexpr int BM = 256, BK = 64, HALF = 128, HTB = HALF * BK * 2  , STAGE_BYTES = 8 * HTB, NXCD = 8, WGM = 8;

__host__ __device__ __forceinline__ int lds_byte(int r, int c) { const int st = (r >> 4) * 2 + (c >> 5), rr = r & 15, cc = c & 31, ob = rr * 64 + cc * 2; return st * 1024 + (ob ^ (((ob >> 9) & 1) << 5)); }
__host__ __device__ __forceinline__ void stage_rc(int b, int& R, int& C) { const int st = b / 1024, sb = b % 1024, swz = sb ^ (((sb >> 9) & 1) << 5); R = (st >> 1) * 16 + swz / 64; C = (st & 1) * 32 + (swz % 64) / 2; }
__host__ __device__ __forceinline__ int perm32(int rho) { const int n = rho >> 4, i = rho & 15; return 8 * (i >> 2) + 4 * n + (i & 3); }

struct Unit { int pm, pn; };
struct Gemm { const bf16_t* A; const bf16_t* Bt; int M, N, K; };

struct StaticOrder {
    int nM, nN, nwg, G, c;
    __host__ __device__ void init(int M, int N, int G_, int c_) { nM = M / BM; nN = N / BM; nwg = nM * nN; G = G_; c = c_; }
    __host__ __device__ bool next(int i, Unit& u) const {
        const long L = (long)i * G + c; if (L >= nwg) return false;
        int wgid = (int)L; { const int q = nwg / NXCD, r = nwg % NXCD, xcd = wgid % NXCD, off = wgid / NXCD; wgid = (xcd < r ? xcd * (q + 1) : r * (q + 1) + (xcd - r) * q) + off; }
        const int nig = WGM * nN, gid = wgid / nig, fm = gid * WGM, gsz = (nM - fm) < WGM ? (nM - fm) : WGM;
        u.pm = fm + ((wgid % nig) % gsz); u.pn = (wgid % nig) / gsz; return true;
    }
    __device__ __forceinline__ void a_ready(const Unit&) const {}
    __device__ __forceinline__ void done(const Unit&) const {}
};


struct EpiSwiGLU {
    static constexpr bool PERM = true, AFTER_DRAIN = false, HAS_MID = false;
    bf16_t* O; int ldc; const float* ssq;
    __device__ __forceinline__ void operator()(const f32x4 (&acc)[2][2][4][2], const Unit& u, int wr, int wc, int fr, int fq) const {
        const int row0 = u.pm * BM + wr * 64 + fr, col0 = u.pn * HALF + wc * 32 + 8 * fq;
#pragma unroll
        for (int ai = 0; ai < 2; ++ai)
#pragma unroll
            for (int m = 0; m < 4; ++m) { const int row = row0 + ai * HALF + m * 16; bf16_t* rowp = O + blk(row, col0, ldc);
                const float rs = ssq ? 1.0f / sqrtf(ssq[row] * (1.0f / D) + RMS_EPS) : 1.0f;
                const f32x4 a0 = acc[ai][0][m][0] * rs, a1 = acc[ai][0][m][1] * rs, b0 = acc[ai][1][m][0] * rs, b1 = acc[ai][1][m][1] * rs;
                u32x4 w; w.x = pk2(fsilu(a0[0]) * b0[0], fsilu(a0[1]) * b0[1]); w.y = pk2(fsilu(a0[2]) * b0[2], fsilu(a0[3]) * b0[3]);
                w.z = pk2(fsilu(a1[0]) * b1[0], fsilu(a1[1]) * b1[1]); w.w = pk2(fsilu(a1[2]) * b1[2], fsilu(a1[3]) * b1[3]);
                *(u32x4*)rowp = w; }
    }
};
struct EpiResid {
    static constexpr bool PERM = false, AFTER_DRAIN = false, HAS_MID = false;
    const float* base; float* out; int ldc; float alpha;
    __device__ __forceinline__ void operator()(const f32x4 (&acc)[2][2][4][2], const Unit& u, int wr, int wc, int fr, int fq) const {
        const int row0 = u.pm * BM + wr * 64 + fr, col0 = u.pn * BM + wc * 32 + 4 * fq;
#pragma unroll
        for (int ai = 0; ai < 2; ++ai)
#pragma unroll
            for (int m = 0; m < 4; ++m) { const size_t off = (size_t)(row0 + ai * HALF + m * 16) * ldc + col0;
#pragma unroll
                for (int bj = 0; bj < 2; ++bj)
#pragma unroll
                    for (int n = 0; n < 2; ++n) { const f32x4 b = *(const f32x4*)(base + off + bj * HALF + n * 16); *(f32x4*)(out + off + bj * HALF + n * 16) = b + acc[ai][bj][m][n] * alpha; } }
    }
};
template <int MODE>
struct EpiResidX {
    static constexpr bool PERM = true, AFTER_DRAIN = false, HAS_MID = false;
    const float* base; const bf16_t* bb; float* out; float alpha; bf16_t* xb; float* ssq;
    __device__ __forceinline__ void operator()(const f32x4 (&acc)[2][2][4][2], const Unit& u, int wr, int wc, int fr, int fq) const {
        const int row0 = u.pm * BM + wr * 64 + fr, col0 = u.pn * BM + wc * 32 + 8 * fq;
#pragma unroll
        for (int ai = 0; ai < 2; ++ai)
#pragma unroll
            for (int m = 0; m < 4; ++m) { const int row = row0 + ai * HALF + m * 16; const size_t off = (size_t)row * D + col0; float s = 0.f;
#pragma unroll
                for (int bj = 0; bj < 2; ++bj) {
                    f32x4 v0, v1;
                    if (MODE == 0) { v0 = *(const f32x4*)(base + off + bj * HALF); v1 = *(const f32x4*)(base + off + bj * HALF + 4); }
                    else { const u32x4 r = *(const u32x4*)(bb + blk(row, col0 + bj * HALF, D)); v0 = (f32x4){bflo(r.x), bfhi(r.x), bflo(r.y), bfhi(r.y)}; v1 = (f32x4){bflo(r.z), bfhi(r.z), bflo(r.w), bfhi(r.w)}; }
                    v0 += acc[ai][bj][m][0] * alpha; v1 += acc[ai][bj][m][1] * alpha;
                    if (MODE == 2) { *(f32x4*)(out + off + bj * HALF) = v0; *(f32x4*)(out + off + bj * HALF + 4) = v1; }
                    else {
                        s += (v0[0] * v0[0] + v0[1] * v0[1]) + (v0[2] * v0[2] + v0[3] * v0[3]) + (v1[0] * v1[0] + v1[1] * v1[1]) + (v1[2] * v1[2] + v1[3] * v1[3]);
                        u32x4 w; w.x = pk2(v0[0], v0[1]); w.y = pk2(v0[2], v0[3]); w.z = pk2(v1[0], v1[1]); w.w = pk2(v1[2], v1[3]); *(u32x4*)(xb + blk(row, col0 + bj * HALF, D)) = w; } }
                if (MODE != 2) { s += __shfl_xor(s, 16); s += __shfl_xor(s, 32); if (fq == 0) unsafeAtomicAdd(ssq + row, s); } }
    }
};
struct EpiP {
    static constexpr bool PERM = true, AFTER_DRAIN = false, HAS_MID = false;
    bf16_t* O; int ldc; const float* ssq;
    __device__ __forceinline__ void operator()(const f32x4 (&acc)[2][2][4][2], const Unit& u, int wr, int wc, int fr, int fq) const {
        const int row0 = u.pm * BM + wr * 64 + fr, colt = u.pn * BM, col0 = colt + wc * 32 + 8 * fq;
        const int mode = (colt >= PC_GA || (colt >= PC_MO && colt < PC_SQ)) ? 1 : ((colt >= PC_SQ && colt < PC_SK) ? 2 : 0);
#pragma unroll
        for (int ai = 0; ai < 2; ++ai)
#pragma unroll
            for (int m = 0; m < 4; ++m) { const int row = row0 + ai * HALF + m * 16; bf16_t* rowp = O + (size_t)row * ldc + col0;
                const float rs = 1.0f / sqrtf(ssq[row] * (1.0f / D) + RMS_EPS);
#pragma unroll
                for (int bj = 0; bj < 2; ++bj) { f32x4 v0 = acc[ai][bj][m][0] * rs, v1 = acc[ai][bj][m][1] * rs;
                    if (mode == 1) {
#pragma unroll
                        for (int j = 0; j < 4; ++j) { v0[j] = fsigmoid(v0[j]); v1[j] = fsigmoid(v1[j]); } }
                    else if (mode == 2) { v0 = v0 * 0.08838834764831845f; v1 = v1 * 0.08838834764831845f; }
                    u32x4 w; w.x = pk2(v0[0], v0[1]); w.y = pk2(v0[2], v0[3]); w.z = pk2(v1[0], v1[1]); w.w = pk2(v1[2], v1[3]);
                    *(u32x4*)(rowp + bj * HALF) = w; } }
    }
};
struct EpiProjAB {
    static constexpr bool PERM = true, AFTER_DRAIN = false, HAS_MID = true;
    const bf16_t* P; bf16_t* MG;
    __device__ __forceinline__ void mid(f32x4 (&acc)[2][2][4][2], const Unit& u, int wr, int wc, int fr, int fq) const {
        int row0 = u.pm * BM + wr * 64 + fr; const int col0 = u.pn * BM + wc * 32 + 8 * fq;
        asm volatile("" : "+v"(row0));
#pragma unroll
        for (int ai = 0; ai < 2; ++ai)
#pragma unroll
            for (int m = 0; m < 4; ++m) { const bf16_t* pr = P + (size_t)(row0 + ai * HALF + m * 16) * NP + col0;
#pragma unroll
                for (int bj = 0; bj < 2; ++bj) { const u32x4 a = *(const u32x4*)(pr + PC_GA + bj * HALF), b = *(const u32x4*)(pr + PC_GB + bj * HALF);
                    const f32x4 b0 = {bflo(b.x), bfhi(b.x), bflo(b.y), bfhi(b.y)}, b1 = {bflo(b.z), bfhi(b.z), bflo(b.w), bfhi(b.w)};
                    const f32x4 a0 = {bflo(a.x), bfhi(a.x), bflo(a.y), bfhi(a.y)}, a1 = {bflo(a.z), bfhi(a.z), bflo(a.w), bfhi(a.w)};
                    f32x4 r0, r1;
#pragma unroll
                    for (int j = 0; j < 4; ++j) { r0[j] = a0[j] * __builtin_amdgcn_rcpf(fmaxf(b0[j], 1e-30f)); r1[j] = a1[j] * __builtin_amdgcn_rcpf(fmaxf(b1[j], 1e-30f)); }
                    acc[ai][bj][m][0] *= r0; acc[ai][bj][m][1] *= r1; }
                asm volatile("" ::: "memory"); }
    }
    __device__ __forceinline__ void operator()(const f32x4 (&acc)[2][2][4][2], const Unit& u, int wr, int wc, int fr, int fq) const {
        int row0 = u.pm * BM + wr * 64 + fr; const int col0 = u.pn * BM + wc * 32 + 8 * fq;
        asm volatile("" : "+v"(row0));
#pragma unroll
        for (int ai = 0; ai < 2; ++ai)
#pragma unroll
            for (int m = 0; m < 4; ++m) { const int row = row0 + ai * HALF + m * 16;
#pragma unroll
                for (int bj = 0; bj < 2; ++bj) { const int c = col0 + bj * HALF; const u32x4 b = *(const u32x4*)(P + (size_t)row * NP + PC_GB + c);
                    const f32x4 b0 = {bflo(b.x), bfhi(b.x), bflo(b.y), bfhi(b.y)}, b1 = {bflo(b.z), bfhi(b.z), bflo(b.w), bfhi(b.w)};
                    const f32x4 v0 = acc[ai][bj][m][0] * b0, v1 = acc[ai][bj][m][1] * b1;
                    u32x4 w; w.x = pk2(v0[0], v0[1]); w.y = pk2(v0[2], v0[3]); w.z = pk2(v1[0], v1[1]); w.w = pk2(v1[2], v1[3]);
                    *(u32x4*)(MG + blk(row, c, D)) = w; } }
    }
};

struct EpiProjA {
    static constexpr bool PERM = false, AFTER_DRAIN = false, HAS_MID = false;
    float* T; const bf16_t* P;
    __device__ __forceinline__ void operator()(const f32x4 (&acc)[2][2][4][2], const Unit& u, int wr, int wc, int fr, int fq) const {
        const int row0 = u.pm * BM + wr * 64 + fr, col0 = u.pn * BM + wc * 32 + 4 * fq;
#pragma unroll
        for (int ai = 0; ai < 2; ++ai)
#pragma unroll
            for (int m = 0; m < 4; ++m) { const int row = row0 + ai * HALF + m * 16;
#pragma unroll
                for (int bj = 0; bj < 2; ++bj)
#pragma unroll
                    for (int n = 0; n < 2; ++n) { const int c = col0 + bj * HALF + n * 16; const u32x2 g = *(const u32x2*)(P + (size_t)row * NP + PC_GA + c);
                        const f32x4 gv = {bflo(g.x), bfhi(g.x), bflo(g.y), bfhi(g.y)}; *(f32x4*)(T + (size_t)row * D + c) = acc[ai][bj][m][n] * gv; } }
    }
};
struct EpiProjB {
    static constexpr bool PERM = true, AFTER_DRAIN = false, HAS_MID = false;
    const float* T; const bf16_t* P; bf16_t* MG;
    __device__ __forceinline__ void operator()(const f32x4 (&acc)[2][2][4][2], const Unit& u, int wr, int wc, int fr, int fq) const {
        const int row0 = u.pm * BM + wr * 64 + fr, col0 = u.pn * BM + wc * 32 + 8 * fq;
#pragma unroll
        for (int ai = 0; ai < 2; ++ai)
#pragma unroll
            for (int m = 0; m < 4; ++m) { const int row = row0 + ai * HALF + m * 16;
#pragma unroll
                for (int bj = 0; bj < 2; ++bj) { const int c = col0 + bj * HALF; const u32x4 g = *(const u32x4*)(P + (size_t)row * NP + PC_GB + c);
                    const f32x4 t0 = *(const f32x4*)(T + (size_t)row * D + c), t1 = *(const f32x4*)(T + (size_t)row * D + c + 4);
                    const f32x4 g0 = {bflo(g.x), bfhi(g.x), bflo(g.y), bfhi(g.y)}, g1 = {bflo(g.z), bfhi(g.z), bflo(g.w), bfhi(g.w)};
                    const f32x4 v0 = t0 + acc[ai][bj][m][0] * g0, v1 = t1 + acc[ai][bj][m][1] * g1;
                    u32x4 w; w.x = pk2(v0[0], v0[1]); w.y = pk2(v0[2], v0[3]); w.z = pk2(v1[0], v1[1]); w.w = pk2(v1[2], v1[3]);
                    *(u32x4*)(MG + (size_t)row * D + c) = w; } }
    }
};

template <class Epi, class Sched, bool ALIGN_EPI = false, bool SP2 = false>
__device__ __forceinline__ void gemm_phase(PG8_LAS unsigned char* lds, const Gemm g, const Sched& S, const Epi& E) {
    const int tid = threadIdx.x, wid = __builtin_amdgcn_readfirstlane(tid >> 6), lane = tid & 63, wr = wid >> 2, wc = wid & 3, fr = lane & 15, fq = lane >> 4;
    const int K = g.K, nt = K / BK;
    unsigned voffA[2], voffB[2];
#pragma unroll
    for (int i = 0; i < 2; ++i) { int R, C; stage_rc(tid * 16 + i * 8192, R, C); const int Rb = Epi::PERM ? ((R & ~31) + perm32(R & 31)) : R;
        voffA[i] = (unsigned)(R * 64 + C) * 2u; voffB[i] = (unsigned)(Rb * 64 + C) * 2u; }
    const size_t kstep = (size_t)(BM * BK * 2);
    const size_t hstep = (size_t)HALF * BK * 2;
    const size_t tstep = (size_t)K * BM * 2;
    const unsigned ldsw = (unsigned)wid * 1024u;
    const int aoff = lds_byte(wr * 64 + fr, fq * 8), boff = lds_byte(wc * 32 + fr, fq * 8);
#define PG8_SA(b, h) (((b) * 2 + (h)) * HTB)
#define PG8_SB(b, h) ((4 + (b) * 2 + (h)) * HTB)
#define PG8_STAGE(bufoff, gbase, voff) do { _Pragma("unroll") for (int _i = 0; _i < 2; ++_i) \
        __builtin_amdgcn_global_load_lds((const unsigned*)((const char*)(gbase) + (voff)[_i]), (PG8_LAS unsigned*)(lds + (bufoff) + ldsw + _i * 8192), 16, 0, 0); } while (0)
#define PG8_LDA(dst, b, h) do { _Pragma("unroll") for (int m = 0; m < 4; ++m) _Pragma("unroll") for (int k = 0; k < 2; ++k) dst[m][k] = *(const PG8_LAS bf16x8*)(lds + PG8_SA(b, h) + aoff + m * 2048 + k * 1024); } while (0)
#define PG8_LDB(dst, b, h) do { _Pragma("unroll") for (int n = 0; n < 2; ++n) _Pragma("unroll") for (int k = 0; k < 2; ++k) dst[n][k] = *(const PG8_LAS bf16x8*)(lds + PG8_SB(b, h) + boff + n * 2048 + k * 1024); } while (0)
#define PG8_MMA(ai, bj, At, Bt) do { __builtin_amdgcn_s_setprio(1); _Pragma("unroll") for (int m = 0; m < 4; ++m) _Pragma("unroll") for (int n = 0; n < 2; ++n) _Pragma("unroll") for (int k = 0; k < 2; ++k) \
        acc[ai][bj][m][n] = __builtin_amdgcn_mfma_f32_16x16x32_bf16(Bt[n][k], At[m][k], acc[ai][bj][m][n], 0, 0, 0); __builtin_amdgcn_s_setprio(0); } while (0)
#define PG8_WAIT_V(n) asm volatile("s_waitcnt vmcnt(" #n ")" ::: "memory")
#define PG8_WAIT_L(n) asm volatile("s_waitcnt lgkmcnt(" #n ")" ::: "memory")
#define PG8_BAR __builtin_amdgcn_s_barrier()
#define PG8_SCHED __builtin_amdgcn_sched_barrier(0)
    Unit cur, nxt; int ui = 0;
    if (!S.next(0, cur)) return;
    f32x4 acc[2][2][4][2];
#pragma unroll
    for (int a = 0; a < 2; ++a)
#pragma unroll
        for (int b = 0; b < 2; ++b)
#pragma unroll
            for (int m = 0; m < 4; ++m)
#pragma unroll
                for (int n = 0; n < 2; ++n) acc[a][b][m][n] = (f32x4){0.f, 0.f, 0.f, 0.f};
    bf16x8 At[4][2], B0[2][2], B1[2][2];
    const char* cA = (const char*)g.A + (size_t)cur.pm * tstep; const char* cB = (const char*)g.Bt + (size_t)cur.pn * tstep;
    long cks = (long)kstep;
    S.a_ready(cur);
    if constexpr (SP2) {
        PG8_STAGE(PG8_SB(0, 0), cB, voffB); PG8_STAGE(PG8_SB(0, 1), cB + hstep, voffB); PG8_STAGE(PG8_SA(0, 0), cA, voffA); PG8_STAGE(PG8_SA(0, 1), cA + hstep, voffA);
        if (wr == 1) PG8_BAR;
        PG8_WAIT_V(2); PG8_BAR;
        PG8_STAGE(PG8_SB(1, 0), cB + cks, voffB); PG8_STAGE(PG8_SA(1, 0), cA + cks, voffA); PG8_STAGE(PG8_SB(1, 1), cB + hstep + cks, voffB);
        PG8_WAIT_V(6); PG8_BAR;
    } else {
        PG8_STAGE(PG8_SB(0, 0), cB, voffB); PG8_STAGE(PG8_SA(0, 0), cA, voffA); PG8_STAGE(PG8_SB(0, 1), cB + hstep, voffB); PG8_STAGE(PG8_SA(0, 1), cA + hstep, voffA);
        if (wr == 1) PG8_BAR;
        PG8_WAIT_V(4); PG8_BAR;
        PG8_STAGE(PG8_SB(1, 0), cB + cks, voffB); PG8_STAGE(PG8_SA(1, 0), cA + cks, voffA); PG8_STAGE(PG8_SB(1, 1), cB + hstep + cks, voffB);
        PG8_WAIT_V(6); PG8_BAR;
    }
    for (;;) {
        const bool has_next = S.next(ui + 1, nxt);
        const bool nrev = PG_KREV && !Epi::HAS_MID && has_next && (((ui + 1) & 1) != 0);
        const long nks = has_next ? (nrev ? -(long)kstep : (long)kstep) : cks;
        const char* nA = has_next ? (const char*)g.A + (size_t)nxt.pm * tstep + (nrev ? (size_t)(nt - 1) * kstep : 0) : cA; const char* nB = has_next ? (const char*)g.Bt + (size_t)nxt.pn * tstep + (nrev ? (size_t)(nt - 1) * kstep : 0) : cB;
        constexpr int NSEG = Epi::HAS_MID ? 2 : 1; int t = 0;
#pragma unroll
        for (int seg = 0; seg < NSEG; ++seg) { const int tend = (seg + 1 < NSEG) ? (nt >> 1) : nt;
        for (; t < tend; t += 2) {
            const bool last = (t == nt - 2);
            const char* a1 = cA + (long)(t + 1) * cks;
            const char* a2 = last ? nA : cA + (long)(t + 2) * cks; const char* b2 = last ? nB : cB + (long)(t + 2) * cks;
            const long s3 = last ? nks : cks; const char* a3 = a2 + s3; const char* b3 = b2 + s3;
            if (last && has_next) S.a_ready(nxt);
            if constexpr (SP2) {
            PG8_LDB(B0, 0, 0); PG8_LDB(B1, 0, 1); PG8_SCHED; PG8_LDA(At, 0, 0); PG8_STAGE(PG8_SA(1, 1), a1 + hstep, voffA);
            PG8_WAIT_V(8); PG8_WAIT_L(0); PG8_BAR; PG8_MMA(0, 0, At, B0); PG8_MMA(0, 1, At, B1); PG8_BAR; PG8_SCHED;
            PG8_LDA(At, 0, 1); PG8_STAGE(PG8_SB(0, 0), b2, voffB); PG8_STAGE(PG8_SB(0, 1), b2 + hstep, voffB); PG8_STAGE(PG8_SA(0, 0), a2, voffA);
            PG8_WAIT_V(8); PG8_WAIT_L(0); PG8_BAR; PG8_MMA(1, 0, At, B0); PG8_MMA(1, 1, At, B1); PG8_BAR; PG8_SCHED;
            PG8_LDB(B0, 1, 0); PG8_LDB(B1, 1, 1); PG8_SCHED; PG8_LDA(At, 1, 0); PG8_STAGE(PG8_SA(0, 1), a2 + hstep, voffA);
            PG8_WAIT_V(8); PG8_WAIT_L(0); PG8_BAR; PG8_MMA(0, 0, At, B0); PG8_MMA(0, 1, At, B1); PG8_BAR; PG8_SCHED;
            PG8_LDA(At, 1, 1); PG8_STAGE(PG8_SB(1, 0), b3, voffB); PG8_STAGE(PG8_SB(1, 1), b3 + hstep, voffB); PG8_STAGE(PG8_SA(1, 0), a3, voffA);
            PG8_WAIT_V(8); PG8_WAIT_L(0); PG8_BAR; PG8_MMA(1, 0, At, B0); PG8_MMA(1, 1, At, B1); PG8_BAR; PG8_SCHED;
            } else {
            PG8_LDB(B0, 0, 0); PG8_SCHED; PG8_LDA(At, 0, 0); PG8_STAGE(PG8_SA(1, 1), a1 + hstep, voffA);
            PG8_WAIT_L(8); PG8_BAR; PG8_WAIT_L(0); PG8_MMA(0, 0, At, B0); PG8_BAR; PG8_SCHED;
            PG8_LDB(B1, 0, 1); PG8_STAGE(PG8_SB(0, 0), b2, voffB);
            PG8_BAR; PG8_WAIT_L(0); PG8_MMA(0, 1, At, B1); PG8_BAR;
            PG8_LDA(At, 0, 1); PG8_STAGE(PG8_SA(0, 0), a2, voffA);
            PG8_BAR; PG8_WAIT_L(0); PG8_MMA(1, 0, At, B0); PG8_BAR; PG8_SCHED;
            PG8_STAGE(PG8_SB(0, 1), b2 + hstep, voffB);
            PG8_WAIT_V(6); PG8_BAR; PG8_MMA(1, 1, At, B1); PG8_BAR;
            PG8_LDB(B0, 1, 0); PG8_SCHED; PG8_LDA(At, 1, 0); PG8_STAGE(PG8_SA(0, 1), a2 + hstep, voffA);
            PG8_WAIT_L(8); PG8_BAR; PG8_WAIT_L(0); PG8_MMA(0, 0, At, B0); PG8_BAR; PG8_SCHED;
            PG8_LDB(B1, 1, 1); PG8_STAGE(PG8_SB(1, 0), b3, voffB);
            PG8_BAR; PG8_WAIT_L(0); PG8_MMA(0, 1, At, B1); PG8_BAR;
            PG8_LDA(At, 1, 1); PG8_STAGE(PG8_SA(1, 0), a3, voffA);
            PG8_BAR; PG8_WAIT_L(0); PG8_MMA(1, 0, At, B0); PG8_BAR; PG8_SCHED;
            PG8_STAGE(PG8_SB(1, 1), b3 + hstep, voffB);
            PG8_WAIT_V(6); PG8_BAR; PG8_MMA(1, 1, At, B1); PG8_BAR;
            }
        }
        if constexpr (Epi::HAS_MID) { if (seg == 0) E.mid(acc, cur, wr, wc, fr, fq); }
        }
        if constexpr (ALIGN_EPI) { if (wr == 0) PG8_BAR; }
        if constexpr (!Epi::AFTER_DRAIN) { E(acc, cur, wr, wc, fr, fq); S.done(cur); }
        if (!has_next) break;
#pragma unroll
        for (int a = 0; a < 2; ++a)
#pragma unroll
            for (int b = 0; b < 2; ++b)
#pragma unroll
                for (int m = 0; m < 4; ++m)
#pragma unroll
                    for (int n = 0; n < 2; ++n) acc[a][b][m][n] = (f32x4){0.f, 0.f, 0.f, 0.f};
        cur = nxt; cA = nA; cB = nB; cks = nks; ++ui;
        if constexpr (ALIGN_EPI) { if (wr == 1) PG8_BAR; }
    }
    PG8_WAIT_V(0);
    if constexpr (!ALIGN_EPI) { if (wr == 0) PG8_BAR; }
    PG8_BAR;
    if constexpr (Epi::AFTER_DRAIN) { E.fused(acc, cur, wr, wc, fr, fq, lds, wid, lane); S.done(cur); }
#undef PG8_SA
#undef PG8_SB
#undef PG8_STAGE
#undef PG8_LDA
#undef PG8_LDB
#undef PG8_MMA
#undef PG8_WAIT_V
#undef PG8_WAIT_L
#undef PG8_BAR
#undef PG8_SCHED
}
}

#define XB_TMO      128
#define XB_XCNT(j)  (256  + 64 * (j))
#define XB_XSUB(j)  (1280 + 64 * (j))
#define XB_XGEN(j)  (2304 + 64 * (j))
#define XB_TOP      3328
#define XB_TOPGEN   3392
#define XCD_BAR_WORDS 3456
#define XB_SPIN_CAP (1u << 18)

__device__ __forceinline__ unsigned xb_ld(unsigned* p)              { return __hip_atomic_load(p, __ATOMIC_RELAXED, __HIP_MEMORY_SCOPE_AGENT); }
__device__ __forceinline__ unsigned xb_add(unsigned* p, unsigned v) { return __hip_atomic_fetch_add(p, v, __ATOMIC_RELAXED, __HIP_MEMORY_SCOPE_AGENT); }
__device__ __forceinline__ unsigned xb_xcc_id() { return (unsigned)__builtin_amdgcn_s_getreg((3 << 11) | 20) & 0xFu; }
#define XB_SPIN(cond, bar) do { unsigned _sp = 0; while (cond) { __builtin_amdgcn_s_sleep(1); \
    if ((++_sp & 255u) == 0u) { if (xb_ld(&(bar)[XB_TMO])) break; if (_sp > XB_SPIN_CAP) { atomicAdd(&(bar)[XB_TMO], 1u); break; } } } } while (0)

struct XcdBarrier {
    unsigned* bar; unsigned x;
    volatile LAS unsigned* st;
};
__device__ __forceinline__ XcdBarrier xcd_barrier_post(unsigned* bar, volatile LAS unsigned* st) {
    XcdBarrier b; b.bar = bar; b.x = xb_xcc_id(); b.st = st;
    if (threadIdx.x == 0) (void)xb_add(&bar[XB_XCNT(b.x)], 1u);
    return b;
}
__device__ __forceinline__ void xcd_barrier_complete(unsigned* bar, unsigned x, unsigned& nloc, unsigned& nx) {
    const unsigned G = gridDim.x * gridDim.y * gridDim.z;
    unsigned sum, cnt, mine, sp = 0u;
    for (;;) {
        sum = 0u; cnt = 0u; mine = 0u;
#pragma unroll
        for (unsigned j = 0; j < 16; ++j) { const unsigned c = xb_ld(&bar[XB_XCNT(j)]); sum += c; cnt += (c > 0u) ? 1u : 0u; mine = (j == x) ? c : mine; }
        if (sum == G) break;
        __builtin_amdgcn_s_sleep(1);
        if ((++sp & 255u) == 0u) { if (xb_ld(&bar[XB_TMO])) break; if (sp > XB_SPIN_CAP) { atomicAdd(&bar[XB_TMO], 1u); break; } }
    }
    nloc = mine > 0u ? mine : 1u; nx = cnt > 0u ? cnt : 1u;
}
__device__ __forceinline__ void xcd_barrier(const XcdBarrier& b) {
    asm volatile("s_waitcnt vmcnt(0)" ::: "memory");
    __syncthreads();
    if (threadIdx.x == 0) {
        unsigned* bar = b.bar;
        __builtin_amdgcn_s_waitcnt(0);
        unsigned nloc = b.st[0], nx = b.st[1];
        if (nloc == 0u) { xcd_barrier_complete(bar, b.x, nloc, nx); b.st[0] = nloc; b.st[1] = nx; }
        const unsigned old = xb_add(&bar[XB_XSUB(b.x)], 1u);
        const unsigned gen = old / nloc;
        if (old + 1u == (gen + 1u) * nloc) {
            __builtin_amdgcn_fence(__ATOMIC_RELEASE, "agent");
            asm volatile("s_waitcnt vmcnt(0)" ::: "memory");
            const unsigned og = xb_add(&bar[XB_TOP], 1u);
            const unsigned tg = og / nx;
            if (og + 1u == (tg + 1u) * nx) xb_add(&bar[XB_TOPGEN], 1u);
            else XB_SPIN(xb_ld(&bar[XB_TOPGEN]) == tg, bar);
            __builtin_amdgcn_fence(__ATOMIC_ACQUIRE, "agent");
            xb_add(&bar[XB_XGEN(b.x)], 1u);
            asm volatile("s_waitcnt vmcnt(0)" ::: "memory");
        } else {
            XB_SPIN(xb_ld(&bar[XB_XGEN(b.x)]) == gen, bar);
            __builtin_amdgcn_fence(__ATOMIC_ACQUIRE, "agent");
            asm volatile("s_waitcnt vmcnt(0)" ::: "memory");
        }
    }
    __syncthreads();
}

constexpr int RING_BYTES = 131072;
constexpr int LDSCTL_OFF = 143360, MISC_OFF = LDSCTL_OFF + 320;
constexpr int LDS_BYTES = 147456;

constexpr int TR_SCR_BYTES = 64 * 65 * 4;
template <bool GAIN = false>
__device__ __forceinline__ void tr_item(const float* W, size_t ldw, int k0, int c0, bf16* WT, int nd0, int K, LAS float* scr, int lane, const float* gk = nullptr, int kd0 = -1) {
    if (kd0 < 0) kd0 = k0;
#pragma unroll
    for (int i = 0; i < 64; ++i) scr[i * 65 + lane] = __builtin_nontemporal_load(W + (size_t)(k0 + i) * ldw + c0 + lane);
    asm volatile("s_waitcnt lgkmcnt(0)" ::: "memory");
    const int c = lane & 7;
    f32x4 g0 = {1.f, 1.f, 1.f, 1.f}, g1 = g0;
    if (GAIN) { g0 = *(const f32x4*)(gk + k0 + 8 * c); g1 = *(const f32x4*)(gk + k0 + 8 * c + 4); }
#pragma unroll
    for (int j = 0; j < 8; ++j) { const int n = (lane >> 3) + 8 * j; const LAS float* s = scr + (8 * c) * 65 + n;
        u32x4 o; o.x = pk2(s[0 * 65] * g0.x, s[1 * 65] * g0.y); o.y = pk2(s[2 * 65] * g0.z, s[3 * 65] * g0.w); o.z = pk2(s[4 * 65] * g1.x, s[5 * 65] * g1.y); o.w = pk2(s[6 * 65] * g1.z, s[7 * 65] * g1.w);
        *(u32x4*)(WT + blk(nd0 + n, kd0 + 8 * c, K)) = o; }
    asm volatile("s_waitcnt lgkmcnt(0)" ::: "memory");
}
template <bool GAIN = false>
__device__ __forceinline__ void tr_super(const float* W, size_t ldw, int k0, int c0, bf16* WT, int nd0, int K, LAS unsigned char* lds, int wave, int lane, int kd0, const float* gk = nullptr) {
    LAS float* tile = (LAS float*)lds;
#pragma unroll
    for (int r = 0; r < 8; ++r)
#pragma unroll
        for (int h = 0; h < 8; ++h) tile[(8 * wave + r) * 513 + 64 * h + lane] = __builtin_nontemporal_load(W + (size_t)(k0 + 8 * wave + r) * ldw + c0 + 64 * h + lane);
    __syncthreads();
    const int c = lane & 7;
    f32x4 g0 = {1.f, 1.f, 1.f, 1.f}, g1 = g0;
    if (GAIN) { g0 = *(const f32x4*)(gk + k0 + 8 * c); g1 = *(const f32x4*)(gk + k0 + 8 * c + 4); }
#pragma unroll
    for (int j = 0; j < 8; ++j) { const int n = (lane >> 3) + 8 * j; const LAS float* t = tile + (8 * c) * 513 + 64 * wave + n;
        u32x4 o; o.x = pk2(t[0 * 513] * g0.x, t[1 * 513] * g0.y); o.y = pk2(t[2 * 513] * g0.z, t[3 * 513] * g0.w); o.z = pk2(t[4 * 513] * g1.x, t[5 * 513] * g1.y); o.w = pk2(t[6 * 513] * g1.z, t[7 * 513] * g1.w);
        *(u32x4*)(WT + blk(nd0 + 64 * wave + n, kd0 + 8 * c, K)) = o; }
    __syncthreads();
}
__device__ __forceinline__ void tr_plain(const float* W, int K, int N, size_t ldw, int coff, bf16* WT, LAS float* scr, int item, int lane) {
    const int nblk = N / 64, kb = item / nblk, nb = item % nblk;
    tr_item(W, ldw, 64 * kb, coff + 64 * nb, WT, 64 * nb, K, scr, lane);
}
template <bool GAIN = false>
__device__ __forceinline__ void tr_w13(const float* W, int which, bf16* WT, LAS float* scr, int item, int lane, const float* gk = nullptr) {
    const int nblk = FF / 64, kb = item / nblk, nb = item % nblk, n0 = 64 * nb;
    tr_item<GAIN>(W, FF, 64 * kb, n0, WT, (n0 >> 7) * 256 + which * 128 + (n0 & 127), D, scr, lane, gk);
}
__device__ __forceinline__ void gates_rows32(LAS unsigned char* lds, const bf16* XB, const bf16* WGB, const float* ssq, float* GT, int row0, int tid) {
    const int lane = tid & 63, wave = __builtin_amdgcn_readfirstlane(tid >> 6);
    f32x4 acc[2] = {{0.f, 0.f, 0.f, 0.f}, {0.f, 0.f, 0.f, 0.f}};
    const int kb = 512 * wave + 8 * (lane >> 4);
#pragma unroll 4
    for (int ks = 0; ks < 16; ++ks) {
        const bf16x8 bw = *(const bf16x8*)(WGB + (size_t)(lane & 15) * D + kb + 32 * ks);
#pragma unroll
        for (int rb = 0; rb < 2; ++rb) { const bf16x8 a = *(const bf16x8*)(XB + blk(row0 + 16 * rb + (lane & 15), kb + 32 * ks, D));
            acc[rb] = __builtin_amdgcn_mfma_f32_16x16x32_bf16(a, bw, acc[rb], 0, 0, 0); }
    }
    LAS float* red = (LAS float*)lds;
#pragma unroll
    for (int rb = 0; rb < 2; ++rb)
#pragma unroll
        for (int r = 0; r < 4; ++r) red[((wave * 2 + rb) * 4 + r) * 64 + lane] = acc[rb][r];
    __syncthreads();
    {
        const int row = tid >> 4, gate = tid & 15, rb = row >> 4, rr = row & 15, src = ((rr >> 2) << 4) + gate, reg = rr & 3;
        float s = 0.f;
#pragma unroll
        for (int w = 0; w < 8; ++w) s += red[((w * 2 + rb) * 4 + reg) * 64 + src];
        GT[(size_t)(row0 + row) * 16 + gate] = s / sqrtf(ssq[row0 + row] * (1.0f / D) + RMS_EPS);
    }
    __syncthreads();
}

template <int MODE>
__device__ __forceinline__ void norm_row(const float* xrow, const float* g, bf16* hrow, float* orow, const float* wgt, float* grow, int lane, int mrow = 0) {
    const f32x4* xr = (const f32x4*)xrow + lane; const f32x4* gr = (const f32x4*)g + lane;
    f32x4 v[16]; float s = 0.f;
#pragma unroll
    for (int j = 0; j < 16; ++j) { v[j] = __builtin_nontemporal_load(xr + 64 * j); s += (v[j].x * v[j].x + v[j].y * v[j].y) + (v[j].z * v[j].z + v[j].w * v[j].w); }
    const float rstd = 1.0f / sqrtf(wave_sum(s) * (1.0f / D) + RMS_EPS);
#pragma unroll
    for (int j = 0; j < 16; ++j) v[j] = v[j] * rstd * gr[64 * j];
    if (MODE == 2) {
#pragma unroll
        for (int j = 0; j < 16; ++j) ((f32x4*)orow + lane)[64 * j] = v[j];
    } else {
#pragma unroll
        for (int j = 0; j < 16; ++j) { u32x2 w; w.x = pk2(v[j].x, v[j].y); w.y = pk2(v[j].z, v[j].w); *(u32x2*)(hrow + blk(mrow, 4 * lane + 256 * j, D)) = w; }
    }
    if (MODE == 1) {
        float mine = 0.f;
#pragma unroll 1
        for (int c = 0; c < 16; ++c) { const f32x4* wr = (const f32x4*)(wgt + (size_t)c * D) + lane; float p = 0.f;
#pragma unroll
            for (int j = 0; j < 16; ++j) { const f32x4 w = wr[64 * j]; p += (v[j].x * w.x + v[j].y * w.y) + (v[j].z * w.z + v[j].w * w.w); }
            p = wave_sum(p); if (lane == c) mine = p; }
        if (lane < 16) grow[lane] = mine;
    }
}

__device__ __forceinline__ float logsigmoidf_acc(float x) { return fminf(x, 0.f) - log1pf(expf(-fabsf(x))); }

constexpr int KS_STRIDE = 272, VS_STRIDE = 528;
__device__ __forceinline__ void mlstm_passA(LAS unsigned char* lds, const bf16* P, const float* GT, const float* convw, const float* b_i, const float* b_f,
                                            bf16* QC, bf16* KC, float* UL, float* NL, float* SC, int unit, int tid) {
    const int lane = tid & 63, wave = __builtin_amdgcn_readfirstlane(tid >> 6);
    const int h = unit >> 7, c = unit & 127, t0 = c * CH;
    LAS unsigned char* KS = lds; LAS unsigned char* VS = lds + 64 * KS_STRIDE; LAS float* SRC = (LAS float*)(lds + 64 * KS_STRIDE + 64 * VS_STRIDE);
    if (wave == 0) {
        const int t = t0 + lane;
        const float li = GT[t * 16 + h] + b_i[h];
        float b = logsigmoidf_acc(GT[t * 16 + 8 + h] + b_f[h]);
#pragma unroll
        for (int o = 1; o < 64; o <<= 1) { const float y = __shfl_up(b, o); if (lane >= o) b += y; }
        const float blast = __shfl(b, 63);
        const float a = blast - b + li;
        const float amax = wave_max(a);
        SRC[lane] = expf(a - amax);
        if (lane == 0) { SC[(h * NCH + c) * 2] = blast; SC[(h * NCH + c) * 2 + 1] = amax; }
    }
#pragma unroll
    for (int i = 0; i < 4; ++i) { const int id = tid + 512 * i, s = id >> 5, cc = (id & 31) * 8;
        *(LAS u32x4*)(VS + s * VS_STRIDE + cc * 2) = *(const u32x4*)(P + (size_t)(t0 + s) * NP + PC_MV + h * DV + cc); }
    __syncthreads();
    {
        const int s = tid >> 3, cc = (tid & 7) * 16, t = t0 + s;
#pragma unroll
        for (int which = 0; which < 2; ++which) {
            const int pcol = which * 1024 + h * DK + cc;
            float a[16];
#pragma unroll
            for (int i = 0; i < 16; ++i) a[i] = 0.f;
#pragma unroll
            for (int j = 0; j < 4; ++j) { const int tt = t - 3 + j;
                if (tt >= 0) { const u32x4 x0 = *(const u32x4*)(P + (size_t)tt * NP + pcol), x1 = *(const u32x4*)(P + (size_t)tt * NP + pcol + 8);
                    const f32x4* w4 = (const f32x4*)(convw + j * 2048 + pcol); const f32x4 w0 = w4[0], w1 = w4[1], w2 = w4[2], w3 = w4[3];
                    a[0] += w0.x * bflo(x0.x); a[1] += w0.y * bfhi(x0.x); a[2] += w0.z * bflo(x0.y); a[3] += w0.w * bfhi(x0.y);
                    a[4] += w1.x * bflo(x0.z); a[5] += w1.y * bfhi(x0.z); a[6] += w1.z * bflo(x0.w); a[7] += w1.w * bfhi(x0.w);
                    a[8] += w2.x * bflo(x1.x); a[9] += w2.y * bfhi(x1.x); a[10] += w2.z * bflo(x1.y); a[11] += w2.w * bfhi(x1.y);
                    a[12] += w3.x * bflo(x1.z); a[13] += w3.y * bfhi(x1.z); a[14] += w3.z * bflo(x1.w); a[15] += w3.w * bfhi(x1.w); } }
            const float sc = which ? 0.08838834764831845f : 1.0f;
#pragma unroll
            for (int i = 0; i < 16; ++i) a[i] = fsilu(a[i]) * sc;
            bf16* dst = (which ? KC : QC) + (size_t)t * 1024 + h * DK + cc;
            u32x4 o0, o1; o0.x = pk2(a[0], a[1]); o0.y = pk2(a[2], a[3]); o0.z = pk2(a[4], a[5]); o0.w = pk2(a[6], a[7]);
            o1.x = pk2(a[8], a[9]); o1.y = pk2(a[10], a[11]); o1.z = pk2(a[12], a[13]); o1.w = pk2(a[14], a[15]);
            *(u32x4*)dst = o0; *(u32x4*)(dst + 8) = o1;
            if (which) { const float sr = SRC[s];
                o0.x = pk2(a[0] * sr, a[1] * sr); o0.y = pk2(a[2] * sr, a[3] * sr); o0.z = pk2(a[4] * sr, a[5] * sr); o0.w = pk2(a[6] * sr, a[7] * sr);
                o1.x = pk2(a[8] * sr, a[9] * sr); o1.y = pk2(a[10] * sr, a[11] * sr); o1.z = pk2(a[12] * sr, a[13] * sr); o1.w = pk2(a[14] * sr, a[15] * sr);
                *(LAS u32x4*)(KS + s * KS_STRIDE + cc * 2) = o0; *(LAS u32x4*)(KS + s * KS_STRIDE + cc * 2 + 16) = o1; }
        }
    }
    __syncthreads();
    {
        const int hh = lane >> 5, q4 = (lane & 15) >> 2, p4 = lane & 3, g2 = (lane >> 4) & 1;
        f32x16 acc[4];
#pragma unroll
        for (int jb = 0; jb < 4; ++jb)
#pragma unroll
            for (int r = 0; r < 16; ++r) acc[jb][r] = 0.f;
#pragma unroll
        for (int ks = 0; ks < 4; ++ks) { const int rlo = 16 * ks + 8 * hh + q4, rhi = rlo + 4;
            const int vcol = (32 * wave + 16 * g2 + 4 * p4) * 2;
            const bf16x8 af = cat8(ds_tr(VS + rlo * VS_STRIDE + vcol), ds_tr(VS + rhi * VS_STRIDE + vcol));
#pragma unroll
            for (int jb = 0; jb < 4; ++jb) { const int kcol = (32 * jb + 16 * g2 + 4 * p4) * 2;
                const bf16x8 bfr = cat8(ds_tr(KS + rlo * KS_STRIDE + kcol), ds_tr(KS + rhi * KS_STRIDE + kcol));
                acc[jb] = MFMA32(bfr, af, acc[jb]); } }
        bf16* ul = (bf16*)UL + (size_t)unit * (DV * DK) + (size_t)(32 * wave + (lane & 31)) * DK;
#pragma unroll
        for (int jb = 0; jb < 4; ++jb)
#pragma unroll
            for (int gq = 0; gq < 4; ++gq) { u32x2 w; w.x = pk2(acc[jb][4 * gq], acc[jb][4 * gq + 1]); w.y = pk2(acc[jb][4 * gq + 2], acc[jb][4 * gq + 3]);
                *(u32x2*)(ul + 32 * jb + 8 * gq + 4 * hh) = w; }
    }
    if (tid < DK) { float sn = 0.f;
#pragma unroll 8
        for (int s = 0; s < CH; ++s) sn += bf2f(*(LAS const unsigned short*)(KS + s * KS_STRIDE + tid * 2));
        NL[(size_t)unit * DK + tid] = sn; }
    __syncthreads();
}

__device__ __forceinline__ void mlstm_passB(const float* UL, const float* NL, const float* SC, bf16* CST, float* NS, float* MS, int gtid, int nthreads) {
    for (int p = gtid; p < MLH * DV * DK / 2; p += nthreads) {
        const int h = p >> 14, e = (p & 16383) * 2;
        float m = 0.f, c0 = 0.f, c1 = 0.f;
        for (int cb = 0; cb < NCH; cb += 8) {
            f32x2 u[8];
#pragma unroll
            for (int j = 0; j < 8; ++j) u[j] = *(const f32x2*)(UL + (size_t)(h * NCH + cb + j) * (DV * DK) + e);
#pragma unroll
            for (int j = 0; j < 8; ++j) { const int c = cb + j; const float bl = SC[(h * NCH + c) * 2], am = SC[(h * NCH + c) * 2 + 1];
                *(unsigned*)(CST + (size_t)(h * NCH + c) * (DV * DK) + e) = pk2(c0, c1);
                if ((p & 16383) == 0) MS[h * NCH + c] = m;
                const float mn = fmaxf(bl + m, am), al = expf(bl + m - mn), be = expf(am - mn);
                c0 = al * c0 + be * u[j].x; c1 = al * c1 + be * u[j].y; m = mn; }
        }
    }
    for (int p = gtid; p < MLH * DK; p += nthreads) {
        const int h = p >> 7, dk = p & 127; float m = 0.f, n = 0.f;
        for (int c = 0; c < NCH; ++c) { const float bl = SC[(h * NCH + c) * 2], am = SC[(h * NCH + c) * 2 + 1];
            NS[(size_t)(h * NCH + c) * DK + dk] = n;
            const float mn = fmaxf(bl + m, am), al = expf(bl + m - mn), be = expf(am - mn);
            n = al * n + be * NL[(size_t)(h * NCH + c) * DK + dk]; m = mn; }
    }
}

__device__ __forceinline__ void scan_table(const float* SC, int h, LAS f32x2* tab, float* ms, int lane) {
    const f32x2 s0 = *(const f32x2*)(SC + (size_t)(h * NCH + lane) * 2), s1 = *(const f32x2*)(SC + (size_t)(h * NCH + 64 + lane) * 2);
    float i0 = s0.x, i1 = s1.x;
#pragma unroll
    for (int o = 1; o < 64; o <<= 1) { const float y0 = __shfl_up(i0, o), y1 = __shfl_up(i1, o); if (lane >= o) { i0 += y0; i1 += y1; } }
    i1 += __shfl(i0, 63);
    const float g0 = s0.y - i0, g1 = s1.y - i1;
    float p0 = g0, p1 = g1;
#pragma unroll
    for (int o = 1; o < 64; o <<= 1) { const float y0 = __shfl_up(p0, o), y1 = __shfl_up(p1, o); if (lane >= o) { p0 = fmaxf(p0, y0); p1 = fmaxf(p1, y1); } }
    const float e0 = __shfl_up(p0, 1), e1 = __shfl_up(p1, 1), top0 = fmaxf(__shfl(p0, 63), 0.f);
    const float t0 = lane ? fmaxf(e0, 0.f) : 0.f, t1 = lane ? fmaxf(e1, top0) : top0;
    const float m0 = (i0 - s0.x) + t0, m1 = (i1 - s1.x) + t1;
    const float n0 = i0 + fmaxf(t0, g0), n1 = i1 + fmaxf(t1, g1);
    tab[lane] = (f32x2){expf(s0.x + m0 - n0), expf(s0.y - n0)};
    tab[lane + 64] = (f32x2){expf(s1.x + m1 - n1), expf(s1.y - n1)};
    if (ms) { ms[h * NCH + lane] = m0; ms[h * NCH + 64 + lane] = m1; }
}
#ifndef MK_SCAN_BATCH
#define MK_SCAN_BATCH 16
#endif
constexpr int SCAN_BATCH = MK_SCAN_BATCH;
template <int V4>
__device__ __forceinline__ void mlstm_passBv(const float* UL, const float* NL, const float* SC, bf16* CST, float* NS, float* MS, int t, int nthreads, LAS f32x2* tabw, int lane) {
    constexpr int EPT = 4 * V4, PER_HEAD = DV * DK / EPT;
    for (int p = t; p < MLH * PER_HEAD; p += nthreads) {
        const int h = __builtin_amdgcn_readfirstlane(p / PER_HEAD), e = (p % PER_HEAD) * EPT;
        scan_table(SC, h, tabw, ((p - lane) % PER_HEAD) == 0 ? MS : nullptr, lane);
        f32x4 cc[V4];
#pragma unroll
        for (int v = 0; v < V4; ++v) cc[v] = (f32x4){0.f, 0.f, 0.f, 0.f};
        for (int cb = 0; cb < NCH; cb += SCAN_BATCH) {
            f32x4 u[SCAN_BATCH][V4];
#pragma unroll
            for (int j = 0; j < SCAN_BATCH; ++j)
#pragma unroll
                for (int v = 0; v < V4; ++v) { const u32x2 w = *(const u32x2*)((const bf16*)UL + (size_t)(h * NCH + cb + j) * (DV * DK) + e + 4 * v); u[j][v] = (f32x4){bflo(w.x), bfhi(w.x), bflo(w.y), bfhi(w.y)}; }
#pragma unroll
            for (int j = 0; j < SCAN_BATCH; ++j) { const int c = cb + j; const f32x2 ab = tabw[c];
#pragma unroll
                for (int v = 0; v < V4; ++v) { u32x2 w; w.x = pk2(cc[v][0], cc[v][1]); w.y = pk2(cc[v][2], cc[v][3]); *(u32x2*)(CST + (size_t)(h * NCH + c) * (DV * DK) + e + 4 * v) = w; }
#pragma unroll
                for (int v = 0; v < V4; ++v) cc[v] = cc[v] * ab.x + u[j][v] * ab.y; }
        }
    }
    for (int p = t; p < MLH * DK; p += nthreads) {
        const int h = __builtin_amdgcn_readfirstlane(p >> 7), dk = p & 127; float n = 0.f;
        scan_table(SC, h, tabw, nullptr, lane);
        for (int cb = 0; cb < NCH; cb += SCAN_BATCH) {
            float u[SCAN_BATCH];
#pragma unroll
            for (int j = 0; j < SCAN_BATCH; ++j) u[j] = NL[(size_t)(h * NCH + cb + j) * DK + dk];
#pragma unroll
            for (int j = 0; j < SCAN_BATCH; ++j) { const int c = cb + j; const f32x2 ab = tabw[c]; NS[(size_t)(h * NCH + c) * DK + dk] = n; n = ab.x * n + ab.y * u[j]; }
        }
    }
}

__device__ __forceinline__ void mlstm_passB8(const float* UL, const float* NL, const float* SC, bf16* CST, float* NS, float* MS, int t, int nthreads, LAS f32x2* tabw, int lane) {
    constexpr int PER_HEAD = DV * DK / 2;
    for (int p = t; p < MLH * PER_HEAD; p += nthreads) {
        const int h = __builtin_amdgcn_readfirstlane(p / PER_HEAD), e = (p % PER_HEAD) * 2;
        scan_table(SC, h, tabw, ((p - lane) % PER_HEAD) == 0 ? MS : nullptr, lane);
        f32x2 cc = {0.f, 0.f};
        for (int cb = 0; cb < NCH; cb += SCAN_BATCH) {
            unsigned u[SCAN_BATCH];
#pragma unroll
            for (int j = 0; j < SCAN_BATCH; ++j) u[j] = *(const unsigned*)((const bf16*)UL + (size_t)(h * NCH + cb + j) * (DV * DK) + e);
#pragma unroll
            for (int j = 0; j < SCAN_BATCH; ++j) { const int c = cb + j; const f32x2 ab = tabw[c];
                *(unsigned*)(CST + (size_t)(h * NCH + c) * (DV * DK) + e) = pk2(cc.x, cc.y);
                cc = cc * ab.x + (f32x2){bflo(u[j]), bfhi(u[j])} * ab.y; }
        }
    }
    for (int p = t; p < MLH * DK; p += nthreads) {
        const int h = __builtin_amdgcn_readfirstlane(p >> 7), dk = p & 127; float n = 0.f;
        scan_table(SC, h, tabw, nullptr, lane);
        for (int cb = 0; cb < NCH; cb += SCAN_BATCH) {
            float u[SCAN_BATCH];
#pragma unroll
            for (int j = 0; j < SCAN_BATCH; ++j) u[j] = NL[(size_t)(h * NCH + cb + j) * DK + dk];
#pragma unroll
            for (int j = 0; j < SCAN_BATCH; ++j) { const int c = cb + j; const f32x2 ab = tabw[c]; NS[(size_t)(h * NCH + c) * DK + dk] = n; n = ab.x * n + ab.y * u[j]; }
        }
    }
}

__device__ __forceinline__ void mlstm_passC(LAS unsigned char* lds, const bf16* P, const float* GT, const float* b_i, const float* b_f, const bf16* QC, const bf16* KC,
                                            const bf16* CST, const float* NS, const float* MS, const float* gout, bf16* YA, int unit, int tid) {
    const int lane = tid & 63, wave = __builtin_amdgcn_readfirstlane(tid >> 6);
    const int h = unit >> 7, c = unit & 127, t0 = c * CH;
    LAS unsigned char* QS = lds; LAS unsigned char* KS = lds + 64 * KS_STRIDE; LAS unsigned char* VS = lds + 128 * KS_STRIDE;
    LAS float* FB = (LAS float*)(lds + 128 * KS_STRIDE + 64 * VS_STRIDE);
    LAS float* GV = FB; LAS float* CM = FB + 64; LAS float* DEC = FB + 128; LAS float* ENM = FB + 192; LAS float* SSQ = FB + 256; LAS float* NSS = FB + 512;
    if (wave == 0) {
        const int t = t0 + lane;
        const float li = GT[t * 16 + h] + b_i[h];
        float b = logsigmoidf_acc(GT[t * 16 + 8 + h] + b_f[h]);
#pragma unroll
        for (int o = 1; o < 64; o <<= 1) { const float y = __shfl_up(b, o); if (lane >= o) b += y; }
        const float g = li - b; float cm = g;
#pragma unroll
        for (int o = 1; o < 64; o <<= 1) { const float y = __shfl_up(cm, o); if (lane >= o) cm = fmaxf(cm, y); }
        const float mprev = MS[h * NCH + c];
        cm = fmaxf(cm, mprev);
        GV[lane] = g; CM[lane] = cm; DEC[lane] = expf(mprev - cm); ENM[lane] = expf(-(b + cm));
    } else if (wave == 1 || wave == 2) { const int dk = tid - 64; NSS[dk] = NS[(size_t)unit * DK + dk]; }
#pragma unroll
    for (int i = 0; i < 2; ++i) { const int id = tid + 512 * i, s = id >> 4, cc = (id & 15) * 8; const size_t go = (size_t)(t0 + s) * 1024 + h * DK + cc;
        *(LAS u32x4*)(QS + s * KS_STRIDE + cc * 2) = *(const u32x4*)(QC + go); *(LAS u32x4*)(KS + s * KS_STRIDE + cc * 2) = *(const u32x4*)(KC + go); }
#pragma unroll
    for (int i = 0; i < 4; ++i) { const int id = tid + 512 * i, s = id >> 5, cc = (id & 31) * 8;
        *(LAS u32x4*)(VS + s * VS_STRIDE + cc * 2) = *(const u32x4*)(P + (size_t)(t0 + s) * NP + PC_MV + h * DV + cc); }
    const int tb = wave & 1, dvq = wave >> 1, tl = 32 * tb + (lane & 31), hh = lane >> 5, q4 = (lane & 15) >> 2, p4 = lane & 3, g2 = (lane >> 4) & 1;
    bf16x8 cfr[2][8];
    {   const bf16* cst = CST + (size_t)unit * (DV * DK);
#pragma unroll
        for (int db = 0; db < 2; ++db)
#pragma unroll
            for (int ks = 0; ks < 8; ++ks) cfr[db][ks] = *(const bf16x8*)(cst + (size_t)(64 * dvq + 32 * db + (lane & 31)) * DK + 16 * ks + 8 * hh); }
    __builtin_amdgcn_sched_barrier(0);
    __syncthreads();
    bf16x8 qf[8];
#pragma unroll
    for (int ks = 0; ks < 8; ++ks) qf[ks] = *(LAS const bf16x8*)(QS + tl * KS_STRIDE + (16 * ks + 8 * hh) * 2);
    const float cmt = CM[tl], dect = DEC[tl];
    bf16x8 wf[2][2]; float dsum = 0.f;
#pragma unroll
    for (int sb = 0; sb < 2; ++sb) {
        if (sb <= tb) {
            f32x16 st;
#pragma unroll
            for (int r = 0; r < 16; ++r) st[r] = 0.f;
#pragma unroll
            for (int ks = 0; ks < 8; ++ks) { const bf16x8 kf = *(LAS const bf16x8*)(KS + (32 * sb + (lane & 31)) * KS_STRIDE + (16 * ks + 8 * hh) * 2); st = MFMA32(kf, qf[ks], st); }
            float w[16];
#pragma unroll
            for (int r = 0; r < 16; ++r) { const int s = 32 * sb + crow(r, hh); const float e = __expf(GV[s] - cmt); w[r] = (s <= tl) ? st[r] * e : 0.f; dsum += w[r]; }
            wf[sb][0] = pack8(w[0], w[1], w[2], w[3], w[4], w[5], w[6], w[7]);
            wf[sb][1] = pack8(w[8], w[9], w[10], w[11], w[12], w[13], w[14], w[15]);
        } else { wf[sb][0] = (bf16x8){0, 0, 0, 0, 0, 0, 0, 0}; wf[sb][1] = wf[sb][0]; }
    }
    f32x16 acc[2];
#pragma unroll
    for (int db = 0; db < 2; ++db) {
#pragma unroll
        for (int r = 0; r < 16; ++r) acc[db][r] = 0.f;
#pragma unroll
        for (int ks = 0; ks < 8; ++ks) acc[db] = MFMA32(cfr[db][ks], qf[ks], acc[db]);
#pragma unroll
        for (int r = 0; r < 16; ++r) acc[db][r] *= dect;
#pragma unroll
        for (int sb = 0; sb < 2; ++sb) {
            if (sb <= tb) {
#pragma unroll
                for (int sp = 0; sp < 2; ++sp) { const int rlo = 32 * sb + 16 * sp + 4 * hh + q4, rhi = rlo + 8; const int vcol = (64 * dvq + 32 * db + 16 * g2 + 4 * p4) * 2;
                    const bf16x8 vf = cat8(ds_tr(VS + rlo * VS_STRIDE + vcol), ds_tr(VS + rhi * VS_STRIDE + vcol));
                    acc[db] = MFMA32(vf, wf[sb][sp], acc[db]); }
            }
        }
    }
    float qn = 0.f;
#pragma unroll
    for (int j = 0; j < 8; ++j) { const u32x4 qv = *(LAS const u32x4*)(QS + tl * KS_STRIDE + (64 * hh + 8 * j) * 2); const LAS float* nn = NSS + 64 * hh + 8 * j;
        qn += bflo(qv.x) * nn[0] + bfhi(qv.x) * nn[1] + bflo(qv.y) * nn[2] + bfhi(qv.y) * nn[3] + bflo(qv.z) * nn[4] + bfhi(qv.z) * nn[5] + bflo(qv.w) * nn[6] + bfhi(qv.w) * nn[7]; }
    qn += __shfl_xor(qn, 32); dsum += __shfl_xor(dsum, 32);
    const float den = dect * qn + dsum, inv = 1.0f / fmaxf(fabsf(den), ENM[tl]);
    float ss = 0.f;
#pragma unroll
    for (int db = 0; db < 2; ++db)
#pragma unroll
        for (int r = 0; r < 16; ++r) { acc[db][r] *= inv; ss += acc[db][r] * acc[db][r]; }
    ss += __shfl_xor(ss, 32);
    if (hh == 0) SSQ[tl * 4 + dvq] = ss;
    f32x4 gg[2][4]; u32x2 og[2][4];
#pragma unroll
    for (int db = 0; db < 2; ++db)
#pragma unroll
        for (int gq = 0; gq < 4; ++gq) { const int dv0 = 64 * dvq + 32 * db + 8 * gq + 4 * hh;
            gg[db][gq] = *(const f32x4*)(gout + h * DV + dv0); og[db][gq] = *(const u32x2*)(P + (size_t)(t0 + tl) * NP + PC_MO + h * DV + dv0); }
    __syncthreads();
    const float rstd = 1.0f / sqrtf(((SSQ[tl * 4] + SSQ[tl * 4 + 1]) + (SSQ[tl * 4 + 2] + SSQ[tl * 4 + 3])) * (1.0f / DV) + RMS_EPS);
#pragma unroll
    for (int db = 0; db < 2; ++db)
#pragma unroll
        for (int gq = 0; gq < 4; ++gq) { const int dv0 = 64 * dvq + 32 * db + 8 * gq + 4 * hh; const f32x4 g4 = gg[db][gq]; const u32x2 o2 = og[db][gq];
            u32x2 o; o.x = pk2(acc[db][4 * gq] * rstd * g4.x * bflo(o2.x), acc[db][4 * gq + 1] * rstd * g4.y * bfhi(o2.x));
            o.y = pk2(acc[db][4 * gq + 2] * rstd * g4.z * bflo(o2.y), acc[db][4 * gq + 3] * rstd * g4.w * bfhi(o2.y));
            *(u32x2*)(YA + blk(t0 + tl, h * DV + dv0, D)) = o; }
    __syncthreads();
}

__device__ __forceinline__ void sb_unit(LAS unsigned char* vs, const bf16* P, bf16* YB, int hd, int qb, int lane) {
    const int tl = lane & 31, hh = lane >> 5, q4 = (lane & 15) >> 2, p4 = lane & 3, g2 = (lane >> 4) & 1;
    const int t = 32 * qb + tl;
    bf16x8 qf[8];
#pragma unroll
    for (int ks = 0; ks < 8; ++ks) qf[ks] = *(const bf16x8*)(P + (size_t)t * NP + PC_SQ + hd * HD + 16 * ks + 8 * hh);
    f32x16 o[4];
#pragma unroll
    for (int cb = 0; cb < 4; ++cb)
#pragma unroll
        for (int r = 0; r < 16; ++r) o[cb][r] = 0.f;
    float R = 1.f;
    const bf16* kbase = P + (size_t)tl * NP + PC_SK + hd * HD + 8 * hh;
    const bf16* vbase = P + (size_t)(lane >> 4) * NP + PC_SV + hd * HD + (lane & 15) * 8;
    bf16x8 kf[8];
#pragma unroll
    for (int ks = 0; ks < 8; ++ks) kf[ks] = *(const bf16x8*)(kbase + (size_t)(32 * qb) * NP + 16 * ks);
    for (int kt = qb; kt >= 0; --kt) {
        const int s0 = 32 * kt, sn = kt > 0 ? s0 - 32 : s0;
        bf16x8 kn[8]; u32x4 vr[8];
#pragma unroll
        for (int i = 0; i < 8; ++i) vr[i] = *(const u32x4*)(vbase + (size_t)(s0 + 4 * i) * NP);
#pragma unroll
        for (int ks = 0; ks < 8; ++ks) kn[ks] = *(const bf16x8*)(kbase + (size_t)sn * NP + 16 * ks);
        f32x16 z;
#pragma unroll
        for (int r = 0; r < 16; ++r) z[r] = 0.f;
#pragma unroll
        for (int ks = 0; ks < 8; ++ks) z = MFMA32(kf[ks], qf[ks], z);
        float om[16], be[16];
        if (kt == qb) {
#pragma unroll
            for (int r = 0; r < 16; ++r) { const float ex = __builtin_amdgcn_exp2f(fminf(z[r] * 1.44269504f, 80.f)); const float w = __builtin_amdgcn_rcpf(1.0f + ex);
                const bool valid = (s0 + crow(r, hh)) < t; om[r] = valid ? w : 1.f; be[r] = valid ? ex * w : 0.f; }
        } else {
#pragma unroll
            for (int r = 0; r < 16; ++r) { const float ex = __builtin_amdgcn_exp2f(fminf(z[r] * 1.44269504f, 80.f)); const float w = __builtin_amdgcn_rcpf(1.0f + ex); om[r] = w; be[r] = ex * w; }
        }
        float e[16], tot[4], otot[4];
#pragma unroll
        for (int g = 0; g < 4; ++g) { e[4 * g + 3] = 1.f; e[4 * g + 2] = om[4 * g + 3]; e[4 * g + 1] = e[4 * g + 2] * om[4 * g + 2]; e[4 * g] = e[4 * g + 1] * om[4 * g + 1]; tot[g] = e[4 * g] * om[4 * g]; }
#pragma unroll
        for (int g = 0; g < 4; ++g) otot[g] = __shfl_xor(tot[g], 32);
        float so[4], xe[4], base[4];
        so[3] = 1.f; so[2] = tot[3]; so[1] = so[2] * tot[2]; so[0] = so[1] * tot[1];
        xe[3] = 1.f; xe[2] = otot[3]; xe[1] = xe[2] * otot[2]; xe[0] = xe[1] * otot[1];
#pragma unroll
        for (int g = 0; g < 4; ++g) base[g] = R * so[g] * (hh == 0 ? xe[g] * otot[g] : xe[g]);
        const float total = (so[0] * tot[0]) * (xe[0] * otot[0]);
        float p[16];
#pragma unroll
        for (int r = 0; r < 16; ++r) p[r] = be[r] * ((r & 3) == 3 ? base[r >> 2] : base[r >> 2] * e[r]);
        const bf16x8 pf0 = pack8(p[0], p[1], p[2], p[3], p[4], p[5], p[6], p[7]), pf1 = pack8(p[8], p[9], p[10], p[11], p[12], p[13], p[14], p[15]);
#pragma unroll
        for (int i = 0; i < 8; ++i) *(LAS u32x4*)(vs + (4 * i + (lane >> 4)) * KS_STRIDE + (lane & 15) * 16) = vr[i];
        bf16x8 vf[4][2];
#pragma unroll
        for (int cb = 0; cb < 4; ++cb)
#pragma unroll
            for (int sp = 0; sp < 2; ++sp) { const int rlo = 16 * sp + 4 * hh + q4, rhi = rlo + 8; const int vcol = (32 * cb + 16 * g2 + 4 * p4) * 2;
                vf[cb][sp] = cat8(ds_tr(vs + rlo * KS_STRIDE + vcol), ds_tr(vs + rhi * KS_STRIDE + vcol)); }
#pragma unroll
        for (int sp = 0; sp < 2; ++sp)
#pragma unroll
            for (int cb = 0; cb < 4; ++cb) o[cb] = MFMA32(vf[cb][sp], sp ? pf1 : pf0, o[cb]);
        R *= total;
        if (__all(R == 0.f)) break;
#pragma unroll
        for (int ks = 0; ks < 8; ++ks) kf[ks] = kn[ks];
    }
#pragma unroll
    for (int cb = 0; cb < 4; ++cb)
#pragma unroll
        for (int gq = 0; gq < 4; ++gq) { u32x2 w; w.x = pk2(o[cb][4 * gq], o[cb][4 * gq + 1]); w.y = pk2(o[cb][4 * gq + 2], o[cb][4 * gq + 3]);
            *(u32x2*)(YB + blk(t, 2048 + hd * HD + 32 * cb + 8 * gq + 4 * hh, D)) = w; }
}

#ifndef MK_N_LAUNCHES
#define MK_N_LAUNCHES 1
#endif
#ifndef PG_ALIGN
#define PG_ALIGN true
#endif
#ifndef PG_SP2
#define PG_SP2 true
#endif
#ifndef MK_REP5A
#define MK_REP5A 1
#endif
#ifndef MK_REP5S
#define MK_REP5S 1
#endif
#ifndef MK_SIDE_BY_SIDE
#define MK_SIDE_BY_SIDE 1
#endif
#ifndef MK_SCAN_WAVES
#define MK_SCAN_WAVES 4
#endif
constexpr int N_PHASES = 14;
#ifndef MK_REPS
#define MK_REPS {1,1,1,1,1,1,1,1,1,1,1,1,1,1}
#endif
constexpr int REP[N_PHASES] = MK_REPS;
struct Args { const float* in[19]; float* out; unsigned char* ws; int ph_lo, ph_hi; };

constexpr int CW_CVQ = 8192;
__device__ __forceinline__ void cv_tail_w2(const float* W, bf16* WT, unsigned* head, LAS unsigned char* lds, int wave, int lane) {
    constexpr int N = (FF / 64) * 8;
    volatile LAS unsigned* slot = (volatile LAS unsigned*)(lds + 139264);
    for (;;) {
        if (wave == 0 && lane == 0) *slot = __hip_atomic_fetch_add(head, 1u, __ATOMIC_RELAXED, __HIP_MEMORY_SCOPE_AGENT);
        __syncthreads();
        const unsigned o = (unsigned)__builtin_amdgcn_readfirstlane((int)*slot);
        if (o >= (unsigned)N) break;
        tr_super(W, D, 64 * (int)(o >> 3), 512 * (int)(o & 7), WT, 512 * (int)(o & 7), FF, lds, wave, lane, 64 * (int)(o >> 3));
    }
}

__global__ void __launch_bounds__(NTHR, 2) mk_fwd(Args args) {
    extern __shared__ __attribute__((aligned(16))) unsigned char lds_raw[];
    LAS unsigned char* lds = (LAS unsigned char*)lds_raw;
    const int tid = threadIdx.x, lane = tid & 63, wave = __builtin_amdgcn_readfirstlane(tid >> 6);
    const int G = gridDim.x, bx = blockIdx.x;
    for (int u = tid; u < (LDS_BYTES - LDSCTL_OFF) / 4; u += NTHR) ((LAS unsigned*)(lds + LDSCTL_OFF))[u] = 0u;
    __syncthreads();
    unsigned char* ws = args.ws;
    unsigned* ctl = (unsigned*)(ws + WS_CTL);
    const int lo = args.ph_lo, hi = args.ph_hi;
    XcdBarrier bar; bar.bar = ctl + CW_BAR; bar.x = 0; bar.st = nullptr;
    if (hi - lo > 1) bar = xcd_barrier_post(ctl + CW_BAR, (volatile LAS unsigned*)(lds + MISC_OFF) + 8);
#define IN(k) (lo <= (k) && (k) < hi)
#define SEAM(k) do { if (IN(k) && IN((k) + 1)) xcd_barrier(bar); } while (0)
#define REPEAT(k) for (int rep = 0; rep < REP[k]; ++rep)
#define RSEAM(k) do { if (rep + 1 < REP[k]) xcd_barrier(bar); } while (0)

    const float* x = args.in[0];
    bf16* W13_1 = (bf16*)(ws + WS_W13_1); bf16* W2_1 = (bf16*)(ws + WS_W2_1); bf16* W13_2 = (bf16*)(ws + WS_W13_2); bf16* W2_2 = (bf16*)(ws + WS_W2_2);
    bf16* WIN = (bf16*)(ws + WS_WIN); bf16* WPA = (bf16*)(ws + WS_WPA); bf16* WPB = (bf16*)(ws + WS_WPB); bf16* WOUT = (bf16*)(ws + WS_WOUT);
    bf16* H = (bf16*)(ws + WS_H); bf16* U = (bf16*)(ws + WS_U); float* X1 = (float*)(ws + WS_X1); bf16* P = (bf16*)(ws + WS_P);
    bf16* YA = (bf16*)(ws + WS_YA); bf16* YB = YA;     bf16* MG = (bf16*)(ws + WS_H); float* TT = (float*)(ws + WS_U);
    float* UL = (float*)(ws + WS_U); bf16* CST = (bf16*)(ws + WS_H);
    float* GT = (float*)(ws + WS_GATE); float* WG = (float*)(ws + WS_WG); float* SC = (float*)(ws + WS_SC); float* MS = (float*)(ws + WS_MS);
    float* SSQ = (float*)(ws + WS_CTL + CTL_SSQ); bf16* XB = (bf16*)(ws + WS_XB); bf16* XB2 = (bf16*)(ws + WS_XB2); float* X3 = (float*)(ws + WS_X3); bf16* WGB = (bf16*)(ws + WS_WG);
    float* NL = (float*)(ws + WS_NL); float* NS = (float*)(ws + WS_NS); bf16* QC = (bf16*)(ws + WS_QC); bf16* KC = (bf16*)(ws + WS_KC);
    const int gw = bx * NWAVES + wave, NGW = G * NWAVES;

    if (IN(0)) REPEAT(0) {
        LAS float* scr = (LAS float*)(lds + wave * TR_SCR_BYTES);
        constexpr int I13 = (D / 64) * (FF / 64), I2 = (FF / 64) * (D / 64), IIN = (D / 64) * (NP / 64), IPA = (2048 / 64) * (D / 64), IO = (D / 64) * (D / 64);
        constexpr int NITEMS = 4 * I13;
        for (int o = bx; o < 1024; o += G) {
            if (o < 256) tr_super(args.in[11], D, 64 * (o >> 3), 512 * (o & 7), WPA, 512 * (o & 7), D, lds, wave, lane, 64 * (o >> 3));
            else if (o < 512) tr_super(args.in[12], D, 64 * ((o - 256) >> 3), 512 * (o & 7), WPA, 512 * (o & 7), D, lds, wave, lane, 2048 + 64 * ((o - 256) >> 3));
            else tr_super(args.in[13], D, 64 * ((o - 512) >> 3), 512 * (o & 7), WOUT, 512 * (o & 7), D, lds, wave, lane, 64 * ((o - 512) >> 3));
        }
        for (int o = bx; o < (D / 64) * (NP / 512); o += G) { const int kb = o / (NP / 512), n0 = 512 * (o % (NP / 512));
            tr_super<true>(args.in[6], DIN, 64 * kb, n0 + (n0 >= PC_SQ ? 16 : 0), WIN, n0, D, lds, wave, lane, 64 * kb, args.in[5]); }
        for (int it = gw; it < NITEMS; it += NGW) {
            int r = it;
            if (r < I13) { tr_w13<true>(args.in[15], 0, W13_2, scr, r, lane, args.in[14]); continue; } r -= I13;
            if (r < I13) { tr_w13<true>(args.in[16], 1, W13_2, scr, r, lane, args.in[14]); continue; } r -= I13;
            if (r < I13) { tr_w13(args.in[2], 0, W13_1, scr, r, lane); continue; } r -= I13;
            tr_w13(args.in[3], 1, W13_1, scr, r, lane);
        }
        for (int i = bx * NTHR + tid; i < 16 * D; i += G * NTHR) { const int c = i >> 12, k = i & (D - 1); const unsigned w = pk2(args.in[6][(size_t)k * DIN + 6144 + c] * args.in[5][k], 0.f); WGB[i] = (bf16)(w & 0xffffu); }
        for (int m = gw; m < M; m += NGW) norm_row<0>(x + (size_t)m * D, args.in[1], H, nullptr, nullptr, nullptr, lane, m);
        RSEAM(0);
    }
    SEAM(0);
    if (IN(1)) REPEAT(1) {
        pg8::Gemm g{H, W13_1, M, 2 * FF, D}; pg8::StaticOrder S; S.init(M, 2 * FF, G, bx);
        pg8::EpiSwiGLU E{U, FF, nullptr};
        pg8::gemm_phase<pg8::EpiSwiGLU, pg8::StaticOrder, PG_ALIGN, PG_SP2>(lds, g, S, E);
        __syncthreads();
        cv_tail_w2(args.in[4], W2_1, ctl + CW_CVQ, lds, wave, lane);
        RSEAM(1);
    }
    SEAM(1);
    if (IN(2)) REPEAT(2) {
        pg8::Gemm g{U, W2_1, M, D, FF}; pg8::StaticOrder S; S.init(M, D, G, bx);
        pg8::EpiResidX<0> E{x, nullptr, nullptr, 0.5f, XB, SSQ};
        pg8::gemm_phase<pg8::EpiResidX<0>, pg8::StaticOrder, PG_ALIGN, PG_SP2>(lds, g, S, E);
        RSEAM(2);
    }
    SEAM(2);
    if (IN(4)) REPEAT(4) {
        for (int r0 = 32 * bx; r0 < M; r0 += 32 * G) gates_rows32(lds, XB, WGB, SSQ, GT, r0, tid);
        pg8::Gemm g{XB, WIN, M, NP, D}; pg8::StaticOrder S; S.init(M, NP, G, bx);
        pg8::EpiP E{P, NP, SSQ};
        pg8::gemm_phase<pg8::EpiP, pg8::StaticOrder, PG_ALIGN, PG_SP2>(lds, g, S, E);
        RSEAM(4);
    }
    SEAM(4);
    if (IN(5)) REPEAT(5) {
#if MK_SIDE_BY_SIDE == 3
        for (int v = gw * 2; v < SBH * (M / 32); v += NGW * 2)
#pragma unroll 1
            for (int k = 0; k < 2; ++k) { const int u = v + k; sb_unit(lds + wave * (32 * KS_STRIDE), P, YB, (u >> 1) & 15, ((u >> 5) << 1) | (u & 1), lane); }
        __syncthreads();
#endif
        for (int ra = 0; ra < MK_REP5A; ++ra)
        for (int u = bx; u < MLH * NCH; u += G) mlstm_passA(lds, P, GT, args.in[7], args.in[8], args.in[9], QC, KC, UL, NL, SC, u, tid);
#if !MK_SIDE_BY_SIDE
        for (int rs = 0; rs < MK_REP5S; ++rs)
        for (int u = gw; u < SBH * (M / 32); u += NGW) sb_unit(lds + wave * (32 * KS_STRIDE), P, YB, u & 15, u >> 4, lane);
#endif
        RSEAM(5);
    }
    SEAM(5);
#if MK_SIDE_BY_SIDE == 2
    if (IN(6)) REPEAT(6) {
        mlstm_passB8(UL, NL, SC, CST, NS, MS, bx * NTHR + tid, G * NTHR, (LAS f32x2*)(lds + 8 * 32 * KS_STRIDE + wave * 1024), lane);
        for (int v = gw * 2; v < SBH * (M / 32); v += NGW * 2)
#pragma unroll 1
            for (int k = 0; k < 2; ++k) { const int u = v + k; sb_unit(lds + wave * (32 * KS_STRIDE), P, YB, (u >> 1) & 15, ((u >> 5) << 1) | (u & 1), lane); }
        RSEAM(6);
    }
#elif MK_SIDE_BY_SIDE == 3 || MK_SIDE_BY_SIDE == 4
    if (IN(6)) REPEAT(6) { mlstm_passB8(UL, NL, SC, CST, NS, MS, bx * NTHR + tid, G * NTHR, (LAS f32x2*)(lds + wave * 1024), lane); RSEAM(6); }
#elif MK_SIDE_BY_SIDE
    if (IN(6)) REPEAT(6) {
        constexpr int NBW = MK_SCAN_WAVES, NAW = NWAVES - NBW;
        if (wave < NBW) mlstm_passBv<4 / NBW>(UL, NL, SC, CST, NS, MS, bx * (64 * NBW) + tid, G * (64 * NBW), (LAS f32x2*)(lds + 65536 + wave * 1024), lane);
        else {
            for (int v = (bx * NAW + (wave - NBW)) * 4; v < SBH * (M / 32); v += G * NAW * 4)
#pragma unroll 1
                for (int k = 0; k < 4; ++k) { const int u = v + k; sb_unit(lds + (wave - NBW) * (32 * KS_STRIDE), P, YB, (u >> 2) & 15, ((u >> 6) << 2) | (u & 3), lane); }
        }
        RSEAM(6);
    }
#else
    if (IN(6)) REPEAT(6) { mlstm_passB8(UL, NL, SC, CST, NS, MS, bx * NTHR + tid, G * NTHR, (LAS f32x2*)(lds + wave * 1024), lane); RSEAM(6); }
#endif
    SEAM(6);
    if (IN(7)) REPEAT(7) {
        for (int u = bx; u < MLH * NCH; u += G) mlstm_passC(lds, P, GT, args.in[8], args.in[9], QC, KC, CST, NS, MS, args.in[10], YA, u, tid);
#if MK_SIDE_BY_SIDE == 4
        for (int v = gw * 2; v < SBH * (M / 32); v += NGW * 2)
#pragma unroll 1
            for (int k = 0; k < 2; ++k) { const int u = v + k; sb_unit(lds + wave * (32 * KS_STRIDE), P, YB, (u >> 1) & 15, ((u >> 5) << 1) | (u & 1), lane); }
#endif
        RSEAM(7);
    }
    SEAM(7);
#define P8_BODY() do { \
        pg8::Gemm g{YA, WPA, M, D, D}; pg8::StaticOrder S; S.init(M, D, G, bx); pg8::EpiProjAB E{P, MG}; \
        pg8::gemm_phase<pg8::EpiProjAB, pg8::StaticOrder, PG_ALIGN, PG_SP2>(lds, g, S, E); } while (0)
    if (IN(8)) {
        P8_BODY();
#if defined(MK_DUP8)
        xcd_barrier(bar); P8_BODY(); xcd_barrier(bar); P8_BODY();
#endif
    }
    SEAM(8);
    if (IN(9)) REPEAT(9) {
        pg8::Gemm g{MG, WOUT, M, D, D}; pg8::StaticOrder S; S.init(M, D, G, bx);
        pg8::EpiResidX<1> E{nullptr, XB, nullptr, 1.0f, XB2, SSQ + M};
        pg8::gemm_phase<pg8::EpiResidX<1>, pg8::StaticOrder, PG_ALIGN, PG_SP2>(lds, g, S, E);
        RSEAM(9);
    }
    SEAM(9);
    if (IN(11)) REPEAT(11) {
        pg8::Gemm g{XB2, W13_2, M, 2 * FF, D}; pg8::StaticOrder S; S.init(M, 2 * FF, G, bx);
        pg8::EpiSwiGLU E{U, FF, SSQ + M};
        pg8::gemm_phase<pg8::EpiSwiGLU, pg8::StaticOrder, PG_ALIGN, PG_SP2>(lds, g, S, E);
        __syncthreads();
        cv_tail_w2(args.in[17], W2_2, ctl + CW_CVQ + 64, lds, wave, lane);
        RSEAM(11);
    }
    SEAM(11);
    if (IN(12)) REPEAT(12) {
        pg8::Gemm g{U, W2_2, M, D, FF}; pg8::StaticOrder S; S.init(M, D, G, bx);
        pg8::EpiResidX<2> E{nullptr, XB2, X3, 0.5f, nullptr, nullptr};
        pg8::gemm_phase<pg8::EpiResidX<2>, pg8::StaticOrder, PG_ALIGN, PG_SP2>(lds, g, S, E);
        RSEAM(12);
    }
    SEAM(12);
    if (IN(13)) REPEAT(13) {
        for (int m = gw; m < M; m += NGW) norm_row<2>(X3 + (size_t)m * D, args.in[18], nullptr, args.out + (size_t)m * D, nullptr, nullptr, lane);
    }
#if defined(MK_EXTRA_PH)
    if (IN(14)) { if (wave < 4) mlstm_passBv<1>(UL, NL, SC, CST, NS, MS, bx * 256 + tid, G * 256, (LAS f32x2*)(lds + 65536 + wave * 1024), lane); }
    if (IN(15)) { if (wave >= 4) for (int v = (bx * 4 + (wave - 4)) * 4; v < SBH * (M / 32); v += G * 16)
        for (int k = 0; k < 4; ++k) { const int u = v + k; sb_unit(lds + (wave - 4) * (32 * KS_STRIDE), P, YB, (u >> 2) & 15, ((u >> 6) << 2) | (u & 3), lane); } }
#endif
#undef IN
#undef SEAM
}

extern "C" void kernel_launch(void* const* d_in, const int* in_sizes, int n_in, void* d_out, int out_size, void* d_ws, size_t ws_size, hipStream_t stream) {
    static int grid = 0;
    if (grid == 0) {
        if (n_in != 19 || in_sizes[0] != M * D || out_size != M * D || ws_size < WS_END) {
            fprintf(stderr, "kernel_launch: unexpected shapes (n_in %d, in0 %d, out %d, ws %zu < %zu); nothing launched\n", n_in, n_in > 0 ? in_sizes[0] : -1, out_size, ws_size, (size_t)WS_END); grid = -1; return; }
        int dev = 0, cus = 0, per_cu = 0;
        if (hipGetDevice(&dev) != hipSuccess || hipDeviceGetAttribute(&cus, hipDeviceAttributeMultiprocessorCount, dev) != hipSuccess) { grid = -1; return; }
        if (hipFuncSetAttribute((const void*)mk_fwd, hipFuncAttributeMaxDynamicSharedMemorySize, LDS_BYTES) != hipSuccess) { fprintf(stderr, "kernel_launch: hipFuncSetAttribute failed\n"); grid = -1; return; }
        if (hipOccupancyMaxActiveBlocksPerMultiprocessor(&per_cu, (const void*)mk_fwd, NTHR, LDS_BYTES) != hipSuccess || per_cu < 1)
            fprintf(stderr, "kernel_launch: note: occupancy query reports %d workgroups per CU\n", per_cu);
        (void)hipGetLastError();
        grid = cus;
    }
    if (grid < 0) return;
    if (hipMemsetAsync((char*)d_ws + WS_CTL, 0, CTL_ZERO_BYTES, stream) != hipSuccess) { fprintf(stderr, "kernel_launch: memset failed\n"); return; }
    Args a{};
    for (int i = 0; i < 19; ++i) a.in[i] = (const float*)d_in[i];
    a.out = (float*)d_out; a.ws = (unsigned char*)d_ws;
#if defined(MK_EXTRA_PH)
#define MK_EXTRA_AFTER 1
#endif
#if MK_N_LAUNCHES == 1
    a.ph_lo = 0; a.ph_hi = N_PHASES;
    hipLaunchKernelGGL(mk_fwd, dim3(grid), dim3(NTHR), LDS_BYTES, stream, a);
#else
    for (int k = 0; k < N_PHASES; ++k) { a.ph_lo = k; a.ph_hi = k + 1; hipLaunchKernelGGL(mk_fwd, dim3(grid), dim3(NTHR), LDS_BYTES, stream, a); }
#endif
#if defined(MK_EXTRA_AFTER)
    for (int k = 0; k < MK_EXTRA_N; ++k) { a.ph_lo = MK_EXTRA_PH; a.ph_hi = MK_EXTRA_PH + 1; hipLaunchKernelGGL(mk_fwd, dim3(grid), dim3(NTHR), LDS_BYTES, stream, a); }
#endif
    const hipError_t le = hipPeekAtLastError();
    if (le != hipSuccess) fprintf(stderr, "kernel_launch: launch failed: %s\n", hipGetErrorName(le));
}
```

```cpp
#include <hip/hip_runtime.h>
#include <cstdio>
#include <cstdint>

#define LAS __attribute__((address_space(3)))
typedef unsigned short bf16;
typedef short bf16x8 __attribute__((ext_vector_type(8)));
typedef short s16x4 __attribute__((ext_vector_type(4)));
typedef float f32x4 __attribute__((ext_vector_type(4)));
typedef float f32x2 __attribute__((ext_vector_type(2)));
typedef float f32x16 __attribute__((ext_vector_type(16)));
typedef unsigned u32x4 __attribute__((ext_vector_type(4)));
typedef unsigned u32x2 __attribute__((ext_vector_type(2)));
typedef __bf16 bf16x2_t __attribute__((ext_vector_type(2)));

constexpr int M = 8192, D = 4096, FF = 11008, NP = 20480, DIN = 20496;
constexpr int NWAVES = 8, NTHR = 512;
constexpr int MLH = 8, DK = 128, DV = 256, SBH = 16, HD = 128, CH = 64, NCH = M / CH;
constexpr int PC_MQ = 0, PC_MK = 1024, PC_MV = 2048, PC_MO = 4096, PC_SQ = 6144, PC_SK = 8192, PC_SV = 10240, PC_GA = 12288, PC_GB = 16384;
constexpr float RMS_EPS = 1e-6f;

constexpr size_t MiB = 1u << 20;
constexpr size_t WS_CTL = 0, CTL_ZERO_BYTES = 1 * MiB;
constexpr size_t WS_GATE = 1 * MiB;
constexpr size_t WS_WG = 1 * MiB + 512 * 1024;
constexpr size_t WS_SC = 2 * MiB;
constexpr size_t WS_MS = 2 * MiB + 64 * 1024;
constexpr size_t WS_NL = 3 * MiB;
constexpr size_t WS_NS = 4 * MiB;
constexpr size_t WS_QC = 8 * MiB, WS_KC = 24 * MiB;
constexpr size_t WS_W13_1 = 40 * MiB, WS_W2_1 = 212 * MiB, WS_W13_2 = 298 * MiB, WS_W2_2 = 470 * MiB;
constexpr size_t WS_WIN = 556 * MiB, WS_WPA = 716 * MiB, WS_WPB = 732 * MiB, WS_WOUT = 748 * MiB;
constexpr size_t WS_H = 780 * MiB;
constexpr size_t WS_U = 844 * MiB;
constexpr size_t WS_X1 = 1016 * MiB;
constexpr size_t WS_XB = WS_X1;
constexpr size_t WS_P = 1144 * MiB;
constexpr size_t WS_YA = 1464 * MiB, WS_YB = 1496 * MiB;
constexpr size_t WS_END = 1528 * MiB;
constexpr int CW_BAR = 4096;
constexpr size_t CTL_SSQ = 65536;
constexpr size_t WS_X3 = WS_P;
constexpr size_t WS_XB2 = WS_YA;

__host__ __device__ __forceinline__ size_t blk(int r, int k, int K) { return (((size_t)((r >> 8) * (K >> 6) + (k >> 6))) << 14) + (size_t)(((r & 255) << 6) + (k & 63)); }

__device__ __forceinline__ float bf2f(unsigned short b) { return __uint_as_float(((unsigned)b) << 16); }
__device__ __forceinline__ float bflo(unsigned w) { return __uint_as_float(w << 16); }
__device__ __forceinline__ float bfhi(unsigned w) { return __uint_as_float(w & 0xffff0000u); }
__device__ __forceinline__ unsigned pk2(float lo, float hi) { f32x2 v = {lo, hi}; bf16x2_t b = __builtin_convertvector(v, bf16x2_t); return __builtin_bit_cast(unsigned, b); }
__device__ __forceinline__ float fsigmoid(float x) { return __builtin_amdgcn_rcpf(1.0f + __expf(-x)); }
__device__ __forceinline__ float fsilu(float x) { return x * fsigmoid(x); }
__device__ __forceinline__ float wave_sum(float v) {
#pragma unroll
    for (int o = 1; o < 64; o <<= 1) v += __shfl_xor(v, o);
    return v;
}
__device__ __forceinline__ float wave_max(float v) {
#pragma unroll
    for (int o = 1; o < 64; o <<= 1) v = fmaxf(v, __shfl_xor(v, o));
    return v;
}
__device__ __forceinline__ int crow(int r, int hi) { return (r & 3) + 8 * (r >> 2) + 4 * hi; }
typedef short v4i16_t __attribute__((ext_vector_type(4)));
__device__ __forceinline__ s16x4 ds_tr(LAS const unsigned char* p) { return __builtin_bit_cast(s16x4, __builtin_amdgcn_ds_read_tr16_b64_v4i16((LAS v4i16_t*)p)); }
__device__ __forceinline__ bf16x8 cat8(s16x4 lo, s16x4 hi) { return (bf16x8){lo[0], lo[1], lo[2], lo[3], hi[0], hi[1], hi[2], hi[3]}; }
__device__ __forceinline__ bf16x8 pack8(float a0, float a1, float a2, float a3, float a4, float a5, float a6, float a7) {
    u32x4 p; p.x = pk2(a0, a1); p.y = pk2(a2, a3); p.z = pk2(a4, a5); p.w = pk2(a6, a7); return __builtin_bit_cast(bf16x8, p);
}
#define MFMA32(a, b, c) __builtin_amdgcn_mfma_f32_32x32x16_bf16((a), (b), (c), 0, 0, 0)
#define MK_N_LAUNCHES 1
#define MK_SIDE_BY_SIDE 2

namespace pg8 {
#define PG8_LAS __attribute__((address_space(3)))
typedef unsigned short bf16_t;
constexpr int BM = 256, BK = 64, HALF = 128, HTB = HALF * BK * 2  , STAGE_BYTES = 8 * HTB, NXCD = 8, WGM = 8;

__host__ __device__ __forceinline__ int lds_byte(int r, int c) { const int st = (r >> 4) * 2 + (c >> 5), rr = r & 15, cc = c & 31, ob = rr * 64 + cc * 2; return st * 1024 + (ob ^ (((ob >> 9) & 1) << 5)); }
__host__ __device__ __forceinline__ void stage_rc(int b, int& R, int& C) { const int st = b / 1024, sb = b % 1024, swz = sb ^ (((sb >> 9) & 1) << 5); R = (st >> 1) * 16 + swz / 64; C = (st & 1) * 32 + (swz % 64) / 2; }
__host__ __device__ __forceinline__ int perm32(int rho) { const int n = rho >> 4, i = rho & 15; return 8 * (i >> 2) + 4 * n + (i & 3); }

struct Unit { int pm, pn; };
struct Gemm { const bf16_t* A; const bf16_t* Bt; int M, N, K; };

struct StaticOrder {
    int nM, nN, nwg, G, c;
    __host__ __device__ void init(int M, int N, int G_, int c_) { nM = M / BM; nN = N / BM; nwg = nM * nN; G = G_; c = c_; }
    __host__ __device__ bool next(int i, Unit& u) const {
        const long L = (long)i * G + c; if (L >= nwg) return false;
        int wgid = (int)L; { const int q = nwg / NXCD, r = nwg % NXCD, xcd = wgid % NXCD, off = wgid / NXCD; wgid = (xcd < r ? xcd * (q + 1) : r * (q + 1) + (xcd - r) * q) + off; }
        const int nig = WGM * nN, gid = wgid / nig, fm = gid * WGM, gsz = (nM - fm) < WGM ? (nM - fm) : WGM;
        u.pm = fm + ((wgid % nig) % gsz); u.pn = (wgid % nig) / gsz; return true;
    }
    __device__ __forceinline__ void a_ready(const Unit&) const {}
    __device__ __forceinline__ void done(const Unit&) const {}
};


struct EpiSwiGLU {
    static constexpr bool PERM = true, AFTER_DRAIN = false, HAS_MID = false;
    bf16_t* O; int ldc; const float* ssq;
    __device__ __forceinline__ void operator()(const f32x4 (&acc)[2][2][4][2], const Unit& u, int wr, int wc, int fr, int fq) const {
        const int row0 = u.pm * BM + wr * 64 + fr, col0 = u.pn * HALF + wc * 32 + 8 * fq;
#pragma unroll
        for (int ai = 0; ai < 2; ++ai)
#pragma unroll
            for (int m = 0; m < 4; ++m) { const int row = row0 + ai * HALF + m * 16; bf16_t* rowp = O + blk(row, col0, ldc);
                const float rs = ssq ? 1.0f / sqrtf(ssq[row] * (1.0f / D) + RMS_EPS) : 1.0f;
                const f32x4 a0 = acc[ai][0][m][0] * rs, a1 = acc[ai][0][m][1] * rs, b0 = acc[ai][1][m][0] * rs, b1 = acc[ai][1][m][1] * rs;
                u32x4 w; w.x = pk2(fsilu(a0[0]) * b0[0], fsilu(a0[1]) * b0[1]); w.y = pk2(fsilu(a0[2]) * b0[2], fsilu(a0[3]) * b0[3]);
                w.z = pk2(fsilu(a1[0]) * b1[0], fsilu(a1[1]) * b1[1]); w.w = pk2(fsilu(a1[2]) * b1[2], fsilu(a1[3]) * b1[3]);
                *(u32x4*)rowp = w; }
    }
};
struct EpiResid {
    static constexpr bool PERM = false, AFTER_DRAIN = false, HAS_MID = false;
    const float* base; float* out; int ldc; float alpha;
    __device__ __forceinline__ void operator()(const f32x4 (&acc)[2][2][4][2], const Unit& u, int wr, int wc, int fr, int fq) const {
        const int row0 = u.pm * BM + wr * 64 + fr, col0 = u.pn * BM + wc * 32 + 4 * fq;
#pragma unroll
        for (int ai = 0; ai < 2; ++ai)
#pragma unroll
            for (int m = 0; m < 4; ++m) { const size_t off = (size_t)(row0 + ai * HALF + m * 16) * ldc + col0;
#pragma unroll
                for (int bj = 0; bj < 2; ++bj)
#pragma unroll
                    for (int n = 0; n < 2; ++n) { const f32x4 b = *(const f32x4*)(base + off + bj * HALF + n * 16); *(f32x4*)(out + off + bj * HALF + n * 16) = b + acc[ai][bj][m][n] * alpha; } }
    }
};
template <int MODE>
struct EpiResidX {
    static constexpr bool PERM = true, AFTER_DRAIN = false, HAS_MID = false;
    const float* base; const bf16_t* bb; float* out; float alpha; bf16_t* xb; float* ssq;
    __device__ __forceinline__ void operator()(const f32x4 (&acc)[2][2][4][2], const Unit& u, int wr, int wc, int fr, int fq) const {
        const int row0 = u.pm * BM + wr * 64 + fr, col0 = u.pn * BM + wc * 32 + 8 * fq;
#pragma unroll
        for (int ai = 0; ai < 2; ++ai)
#pragma unroll
            for (int m = 0; m < 4; ++m) { const int row = row0 + ai * HALF + m * 16; const size_t off = (size_t)row * D + col0; float s = 0.f;
#pragma unroll
                for (int bj = 0; bj < 2; ++bj) {
                    f32x4 v0, v1;
                    if (MODE == 0) { v0 = *(const f32x4*)(base + off + bj * HALF); v1 = *(const f32x4*)(base + off + bj * HALF + 4); }
                    else { const u32x4 r = *(const u32x4*)(bb + blk(row, col0 + bj * HALF, D)); v0 = (f32x4){bflo(r.x), bfhi(r.x), bflo(r.y), bfhi(r.y)}; v1 = (f32x4){bflo(r.z), bfhi(r.z), bflo(r.w), bfhi(r.w)}; }
                    v0 += acc[ai][bj][m][0] * alpha; v1 += acc[ai][bj][m][1] * alpha;
                    if (MODE == 2) { *(f32x4*)(out + off + bj * HALF) = v0; *(f32x4*)(out + off + bj * HALF + 4) = v1; }
                    else {
                        s += (v0[0] * v0[0] + v0[1] * v0[1]) + (v0[2] * v0[2] + v0[3] * v0[3]) + (v1[0] * v1[0] + v1[1] * v1[1]) + (v1[2] * v1[2] + v1[3] * v1[3]);
                        u32x4 w; w.x = pk2(v0[0], v0[1]); w.y = pk2(v0[2], v0[3]); w.z = pk2(v1[0], v1[1]); w.w = pk2(v1[2], v1[3]); *(u32x4*)(xb + blk(row, col0 + bj * HALF, D)) = w; } }
                if (MODE != 2) { s += __shfl_xor(s, 16); s += __shfl_xor(s, 32); if (fq == 0) unsafeAtomicAdd(ssq + row, s); } }
    }
};
struct EpiP {
    static constexpr bool PERM = true, AFTER_DRAIN = false, HAS_MID = false;
    bf16_t* O; int ldc; const float* ssq;
    __device__ __forceinline__ void operator()(const f32x4 (&acc)[2][2][4][2], const Unit& u, int wr, int wc, int fr, int fq) const {
        const int row0 = u.pm * BM + wr * 64 + fr, colt = u.pn * BM, col0 = colt + wc * 32 + 8 * fq;
        const int mode = (colt >= PC_GA || (colt >= PC_MO && colt < PC_SQ)) ? 1 : ((colt >= PC_SQ && colt < PC_SK) ? 2 : 0);
#pragma unroll
        for (int ai = 0; ai < 2; ++ai)
#pragma unroll
            for (int m = 0; m < 4; ++m) { const int row = row0 + ai * HALF + m * 16; bf16_t* rowp = O + (size_t)row * ldc + col0;
                const float rs = 1.0f / sqrtf(ssq[row] * (1.0f / D) + RMS_EPS);
#pragma unroll
                for (int bj = 0; bj < 2; ++bj) { f32x4 v0 = acc[ai][bj][m][0] * rs, v1 = acc[ai][bj][m][1] * rs;
                    if (mode == 1) {
#pragma unroll
                        for (int j = 0; j < 4; ++j) { v0[j] = fsigmoid(v0[j]); v1[j] = fsigmoid(v1[j]); } }
                    else if (mode == 2) { v0 = v0 * 0.08838834764831845f; v1 = v1 * 0.08838834764831845f; }
                    u32x4 w; w.x = pk2(v0[0], v0[1]); w.y = pk2(v0[2], v0[3]); w.z = pk2(v1[0], v1[1]); w.w = pk2(v1[2], v1[3]);
                    *(u32x4*)(rowp + bj * HALF) = w; } }
    }
};
struct EpiProjAB {
    static constexpr bool PERM = true, AFTER_DRAIN = false, HAS_MID = true;
    const bf16_t* P; bf16_t* MG;
    __device__ __forceinline__ void mid(f32x4 (&acc)[2][2][4][2], const Unit& u, int wr, int wc, int fr, int fq) const {
        int row0 = u.pm * BM + wr * 64 + fr; const int col0 = u.pn * BM + wc * 32 + 8 * fq;
        asm volatile("" : "+v"(row0));
#pragma unroll
        for (int ai = 0; ai < 2; ++ai)
#pragma unroll
            for (int m = 0; m < 4; ++m) { const bf16_t* pr = P + (size_t)(row0 + ai * HALF + m * 16) * NP + col0;
#pragma unroll
                for (int bj = 0; bj < 2; ++bj) { const u32x4 a = *(const u32x4*)(pr + PC_GA + bj * HALF), b = *(const u32x4*)(pr + PC_GB + bj * HALF);
                    const f32x4 b0 = {bflo(b.x), bfhi(b.x), bflo(b.y), bfhi(b.y)}, b1 = {bflo(b.z), bfhi(b.z), bflo(b.w), bfhi(b.w)};
                    const f32x4 a0 = {bflo(a.x), bfhi(a.x), bflo(a.y), bfhi(a.y)}, a1 = {bflo(a.z), bfhi(a.z), bflo(a.w), bfhi(a.w)};
                    f32x4 r0, r1;
#pragma unroll
                    for (int j = 0; j < 4; ++j) { r0[j] = a0[j] * __builtin_amdgcn_rcpf(fmaxf(b0[j], 1e-30f)); r1[j] = a1[j] * __builtin_amdgcn_rcpf(fmaxf(b1[j], 1e-30f)); }
                    acc[ai][bj][m][0] *= r0; acc[ai][bj][m][1] *= r1; }
                asm volatile("" ::: "memory"); }
    }
    __device__ __forceinline__ void operator()(const f32x4 (&acc)[2][2][4][2], const Unit& u, int wr, int wc, int fr, int fq) const {
        int row0 = u.pm * BM + wr * 64 + fr; const int col0 = u.pn * BM + wc * 32 + 8 * fq;
        asm volatile("" : "+v"(row0));
#pragma unroll
        for (int ai = 0; ai < 2; ++ai)
#pragma unroll
            for (int m = 0; m < 4; ++m) { const int row = row0 + ai * HALF + m * 16;
#pragma unroll
                for (int bj = 0; bj < 2; ++bj) { const int c = col0 + bj * HALF; const u32x4 b = *(const u32x4*)(P + (size_t)row * NP + PC_GB + c);
                    const f32x4 b0 = {bflo(b.x), bfhi(b.x), bflo(b.y), bfhi(b.y)}, b1 = {bflo(b.z), bfhi(b.z), bflo(b.w), bfhi(b.w)};
                    const f32x4 v0 = acc[ai][bj][m][0] * b0, v1 = acc[ai][bj][m][1] * b1;
                    u32x4 w; w.x = pk2(v0[0], v0[1]); w.y = pk2(v0[2], v0[3]); w.z = pk2(v1[0], v1[1]); w.w = pk2(v1[2], v1[3]);
                    *(u32x4*)(MG + blk(row, c, D)) = w; } }
    }
};

struct EpiProjA {
    static constexpr bool PERM = false, AFTER_DRAIN = false, HAS_MID = false;
    float* T; const bf16_t* P;
    __device__ __forceinline__ void operator()(const f32x4 (&acc)[2][2][4][2], const Unit& u, int wr, int wc, int fr, int fq) const {
        const int row0 = u.pm * BM + wr * 64 + fr, col0 = u.pn * BM + wc * 32 + 4 * fq;
#pragma unroll
        for (int ai = 0; ai < 2; ++ai)
#pragma unroll
            for (int m = 0; m < 4; ++m) { const int row = row0 + ai * HALF + m * 16;
#pragma unroll
                for (int bj = 0; bj < 2; ++bj)
#pragma unroll
                    for (int n = 0; n < 2; ++n) { const int c = col0 + bj * HALF + n * 16; const u32x2 g = *(const u32x2*)(P + (size_t)row * NP + PC_GA + c);
                        const f32x4 gv = {bflo(g.x), bfhi(g.x), bflo(g.y), bfhi(g.y)}; *(f32x4*)(T + (size_t)row * D + c) = acc[ai][bj][m][n] * gv; } }
    }
};
struct EpiProjB {
    static constexpr bool PERM = true, AFTER_DRAIN = false, HAS_MID = false;
    const float* T; const bf16_t* P; bf16_t* MG;
    __device__ __forceinline__ void operator()(const f32x4 (&acc)[2][2][4][2], const Unit& u, int wr, int wc, int fr, int fq) const {
        const int row0 = u.pm * BM + wr * 64 + fr, col0 = u.pn * BM + wc * 32 + 8 * fq;
#pragma unroll
        for (int ai = 0; ai < 2; ++ai)
#pragma unroll
            for (int m = 0; m < 4; ++m) { const int row = row0 + ai * HALF + m * 16;
#pragma unroll
                for (int bj = 0; bj < 2; ++bj) { const int c = col0 + bj * HALF; const u32x4 g = *(const u32x4*)(P + (size_t)row * NP + PC_GB + c);
                    const f32x4 t0 = *(const f32x4*)(T + (size_t)row * D + c), t1 = *(const f32x4*)(T + (size_t)row * D + c + 4);
                    const f32x4 g0 = {bflo(g.x), bfhi(g.x), bflo(g.y), bfhi(g.y)}, g1 = {bflo(g.z), bfhi(g.z), bflo(g.w), bfhi(g.w)};
                    const f32x4 v0 = t0 + acc[ai][bj][m][0] * g0, v1 = t1 + acc[ai][bj][m][1] * g1;
                    u32x4 w; w.x = pk2(v0[0], v0[1]); w.y = pk2(v0[2], v0[3]); w.z = pk2(v1[0], v1[1]); w.w = pk2(v1[2], v1[3]);
                    *(u32x4*)(MG + (size_t)row * D + c) = w; } }
    }
};

template <class Epi, class Sched, bool ALIGN_EPI = false, bool SP2 = false>
__device__ __forceinline__ void gemm_phase(PG8_LAS unsigned char* lds, const Gemm g, const Sched& S, const Epi& E) {
    const int tid = threadIdx.x, wid = __builtin_amdgcn_readfirstlane(tid >> 6), lane = tid & 63, wr = wid >> 2, wc = wid & 3, fr = lane & 15, fq = lane >> 4;
    const int K = g.K, nt = K / BK;
    unsigned voffA[2], voffB[2];
#pragma unroll
    for (int i = 0; i < 2; ++i) { int R, C; stage_rc(tid * 16 + i * 8192, R, C); const int Rb = Epi::PERM ? ((R & ~31) + perm32(R & 31)) : R;
        voffA[i] = (unsigned)(R * 64 + C) * 2u; voffB[i] = (unsigned)(Rb * 64 + C) * 2u; }
    const size_t kstep = (size_t)(BM * BK * 2);
    const size_t hstep = (size_t)HALF * BK * 2;
    const size_t tstep = (size_t)K * BM * 2;
    const unsigned ldsw = (unsigned)wid * 1024u;
    const int aoff = lds_byte(wr * 64 + fr, fq * 8), boff = lds_byte(wc * 32 + fr, fq * 8);
#define PG8_SA(b, h) (((b) * 2 + (h)) * HTB)
#define PG8_SB(b, h) ((4 + (b) * 2 + (h)) * HTB)
#define PG8_STAGE(bufoff, gbase, voff) do { _Pragma("unroll") for (int _i = 0; _i < 2; ++_i) \
        __builtin_amdgcn_global_load_lds((const unsigned*)((const char*)(gbase) + (voff)[_i]), (PG8_LAS unsigned*)(lds + (bufoff) + ldsw + _i * 8192), 16, 0, 0); } while (0)
#define PG8_LDA(dst, b, h) do { _Pragma("unroll") for (int m = 0; m < 4; ++m) _Pragma("unroll") for (int k = 0; k < 2; ++k) dst[m][k] = *(const PG8_LAS bf16x8*)(lds + PG8_SA(b, h) + aoff + m * 2048 + k * 1024); } while (0)
#define PG8_LDB(dst, b, h) do { _Pragma("unroll") for (int n = 0; n < 2; ++n) _Pragma("unroll") for (int k = 0; k < 2; ++k) dst[n][k] = *(const PG8_LAS bf16x8*)(lds + PG8_SB(b, h) + boff + n * 2048 + k * 1024); } while (0)
#define PG8_MMA(ai, bj, At, Bt) do { __builtin_amdgcn_s_setprio(1); _Pragma("unroll") for (int m = 0; m < 4; ++m) _Pragma("unroll") for (int n = 0; n < 2; ++n) _Pragma("unroll") for (int k = 0; k < 2; ++k) \
        acc[ai][bj][m][n] = __builtin_amdgcn_mfma_f32_16x16x32_bf16(Bt[n][k], At[m][k], acc[ai][bj][m][n], 0, 0, 0); __builtin_amdgcn_s_setprio(0); } while (0)
#define PG8_WAIT_V(n) asm volatile("s_waitcnt vmcnt(" #n ")" ::: "memory")
#define PG8_WAIT_L(n) asm volatile("s_waitcnt lgkmcnt(" #n ")" ::: "memory")
#define PG8_BAR __builtin_amdgcn_s_barrier()
#define PG8_SCHED __builtin_amdgcn_sched_barrier(0)
    Unit cur, nxt; int ui = 0;
    if (!S.next(0, cur)) return;
    f32x4 acc[2][2][4][2];
#pragma unroll
    for (int a = 0; a < 2; ++a)
#pragma unroll
        for (int b = 0; b < 2; ++b)
#pragma unroll
            for (int m = 0; m < 4; ++m)
#pragma unroll
                for (int n = 0; n < 2; ++n) acc[a][b][m][n] = (f32x4){0.f, 0.f, 0.f, 0.f};
    bf16x8 At[4][2], B0[2][2], B1[2][2];
    const char* cA = (const char*)g.A + (size_t)cur.pm * tstep; const char* cB = (const char*)g.Bt + (size_t)cur.pn * tstep;
    S.a_ready(cur);
    if constexpr (SP2) {
        PG8_STAGE(PG8_SB(0, 0), cB, voffB); PG8_STAGE(PG8_SB(0, 1), cB + hstep, voffB); PG8_STAGE(PG8_SA(0, 0), cA, voffA); PG8_STAGE(PG8_SA(0, 1), cA + hstep, voffA);
        if (wr == 1) PG8_BAR;
        PG8_WAIT_V(2); PG8_BAR;
        PG8_STAGE(PG8_SB(1, 0), cB + kstep, voffB); PG8_STAGE(PG8_SA(1, 0), cA + kstep, voffA); PG8_STAGE(PG8_SB(1, 1), cB + hstep + kstep, voffB);
        PG8_WAIT_V(6); PG8_BAR;
    } else {
        PG8_STAGE(PG8_SB(0, 0), cB, voffB); PG8_STAGE(PG8_SA(0, 0), cA, voffA); PG8_STAGE(PG8_SB(0, 1), cB + hstep, voffB); PG8_STAGE(PG8_SA(0, 1), cA + hstep, voffA);
        if (wr == 1) PG8_BAR;
        PG8_WAIT_V(4); PG8_BAR;
        PG8_STAGE(PG8_SB(1, 0), cB + kstep, voffB); PG8_STAGE(PG8_SA(1, 0), cA + kstep, voffA); PG8_STAGE(PG8_SB(1, 1), cB + hstep + kstep, voffB);
        PG8_WAIT_V(6); PG8_BAR;
    }
    for (;;) {
        const bool has_next = S.next(ui + 1, nxt);
        const char* nA = has_next ? (const char*)g.A + (size_t)nxt.pm * tstep : cA; const char* nB = has_next ? (const char*)g.Bt + (size_t)nxt.pn * tstep : cB;
        constexpr int NSEG = Epi::HAS_MID ? 2 : 1; int t = 0;
#pragma unroll
        for (int seg = 0; seg < NSEG; ++seg) { const int tend = (seg + 1 < NSEG) ? (nt >> 1) : nt;
        for (; t < tend; t += 2) {
            const bool last = (t == nt - 2);
            const char* a1 = cA + (size_t)(t + 1) * kstep;
            const char* a2 = last ? nA : cA + (size_t)(t + 2) * kstep; const char* b2 = last ? nB : cB + (size_t)(t + 2) * kstep;
            const char* a3 = a2 + kstep; const char* b3 = b2 + kstep;
            if (last && has_next) S.a_ready(nxt);
            if constexpr (SP2) {
            PG8_LDB(B0, 0, 0); PG8_LDB(B1, 0, 1); PG8_SCHED; PG8_LDA(At, 0, 0); PG8_STAGE(PG8_SA(1, 1), a1 + hstep, voffA);
            PG8_WAIT_V(8); PG8_WAIT_L(0); PG8_BAR; PG8_MMA(0, 0, At, B0); PG8_MMA(0, 1, At, B1); PG8_BAR; PG8_SCHED;
            PG8_LDA(At, 0, 1); PG8_STAGE(PG8_SB(0, 0), b2, voffB); PG8_STAGE(PG8_SB(0, 1), b2 + hstep, voffB); PG8_STAGE(PG8_SA(0, 0), a2, voffA);
            PG8_WAIT_V(8); PG8_WAIT_L(0); PG8_BAR; PG8_MMA(1, 0, At, B0); PG8_MMA(1, 1, At, B1); PG8_BAR; PG8_SCHED;
            PG8_LDB(B0, 1, 0); PG8_LDB(B1, 1, 1); PG8_SCHED; PG8_LDA(At, 1, 0); PG8_STAGE(PG8_SA(0, 1), a2 + hstep, voffA);
            PG8_WAIT_V(8); PG8_WAIT_L(0); PG8_BAR; PG8_MMA(0, 0, At, B0); PG8_MMA(0, 1, At, B1); PG8_BAR; PG8_SCHED;
            PG8_LDA(At, 1, 1); PG8_STAGE(PG8_SB(1, 0), b3, voffB); PG8_STAGE(PG8_SB(1, 1), b3 + hstep, voffB); PG8_STAGE(PG8_SA(1, 0), a3, voffA);
            PG8_WAIT_V(8); PG8_WAIT_L(0); PG8_BAR; PG8_MMA(1, 0, At, B0); PG8_MMA(1, 1, At, B1); PG8_BAR; PG8_SCHED;
            } else {
            PG8_LDB(B0, 0, 0); PG8_SCHED; PG8_LDA(At, 0, 0); PG8_STAGE(PG8_SA(1, 1), a1 + hstep, voffA);
            PG8_WAIT_L(8); PG8_BAR; PG8_WAIT_L(0); PG8_MMA(0, 0, At, B0); PG8_BAR; PG8_SCHED;
            PG8_LDB(B1, 0, 1); PG8_STAGE(PG8_SB(0, 0), b2, voffB);
            PG8_BAR; PG8_WAIT_L(0); PG8_MMA(0, 1, At, B1); PG8_BAR;
            PG8_LDA(At, 0, 1); PG8_STAGE(PG8_SA(0, 0), a2, voffA);
            PG8_BAR; PG8_WAIT_L(0); PG8_MMA(1, 0, At, B0); PG8_BAR; PG8_SCHED;
            PG8_STAGE(PG8_SB(0, 1), b2 + hstep, voffB);
            PG8_WAIT_V(6); PG8_BAR; PG8_MMA(1, 1, At, B1); PG8_BAR;
            PG8_LDB(B0, 1, 0); PG8_SCHED; PG8_LDA(At, 1, 0); PG8_STAGE(PG8_SA(0, 1), a2 + hstep, voffA);
            PG8_WAIT_L(8); PG8_BAR; PG8_WAIT_L(0); PG8_MMA(0, 0, At, B0); PG8_BAR; PG8_SCHED;
            PG8_LDB(B1, 1, 1); PG8_STAGE(PG8_SB(1, 0), b3, voffB);
            PG8_BAR; PG8_WAIT_L(0); PG8_MMA(0, 1, At, B1); PG8_BAR;
            PG8_LDA(At, 1, 1); PG8_STAGE(PG8_SA(1, 0), a3, voffA);
            PG8_BAR; PG8_WAIT_L(0); PG8_MMA(1, 0, At, B0); PG8_BAR; PG8_SCHED;
            PG8_STAGE(PG8_SB(1, 1), b3 + hstep, voffB);
            PG8_WAIT_V(6); PG8_BAR; PG8_MMA(1, 1, At, B1); PG8_BAR;
            }
        }
        if constexpr (Epi::HAS_MID) { if (seg == 0) E.mid(acc, cur, wr, wc, fr, fq); }
        }
        if constexpr (ALIGN_EPI) { if (wr == 0) PG8_BAR; }
        if constexpr (!Epi::AFTER_DRAIN) { E(acc, cur, wr, wc, fr, fq); S.done(cur); }
        if (!has_next) break;
#pragma unroll
        for (int a = 0; a < 2; ++a)
#pragma unroll
            for (int b = 0; b < 2; ++b)
#pragma unroll
                for (int m = 0; m < 4; ++m)
#pragma unroll
                    for (int n = 0; n < 2; ++n) acc[a][b][m][n] = (f32x4){0.f, 0.f, 0.f, 0.f};
        cur = nxt; cA = nA; cB = nB; ++ui;
        if constexpr (ALIGN_EPI) { if (wr == 1) PG8_BAR; }
    }
    PG8_WAIT_V(0);
    if constexpr (!ALIGN_EPI) { if (wr == 0) PG8_BAR; }
    PG8_BAR;
    if constexpr (Epi::AFTER_DRAIN) { E.fused(acc, cur, wr, wc, fr, fq, lds, wid, lane); S.done(cur); }
#undef PG8_SA
#undef PG8_SB
#undef PG8_STAGE
#undef PG8_LDA
#undef PG8_LDB
#undef PG8_MMA
#undef PG8_WAIT_V
#undef PG8_WAIT_L
#undef PG8_BAR
#undef PG8_SCHED
}
}

#define XB_TMO      128
#define XB_XCNT(j)  (256  + 64 * (j))
#define XB_XSUB(j)  (1280 + 64 * (j))
#define XB_XGEN(j)  (2304 + 64 * (j))
#define XB_TOP      3328
#define XB_TOPGEN   3392
#define XCD_BAR_WORDS 3456
#define XB_SPIN_CAP (1u << 18)

__device__ __forceinline__ unsigned xb_ld(unsigned* p)              { return __hip_atomic_load(p, __ATOMIC_RELAXED, __HIP_MEMORY_SCOPE_AGENT); }
__device__ __forceinline__ unsigned xb_add(unsigned* p, unsigned v) { return __hip_atomic_fetch_add(p, v, __ATOMIC_RELAXED, __HIP_MEMORY_SCOPE_AGENT); }
__device__ __forceinline__ unsigned xb_xcc_id() { return (unsigned)__builtin_amdgcn_s_getreg((3 << 11) | 20) & 0xFu; }
#define XB_SPIN(cond, bar) do { unsigned _sp = 0; while (cond) { __builtin_amdgcn_s_sleep(1); \
    if ((++_sp & 255u) == 0u) { if (xb_ld(&(bar)[XB_TMO])) break; if (_sp > XB_SPIN_CAP) { atomicAdd(&(bar)[XB_TMO], 1u); break; } } } } while (0)

struct XcdBarrier {
    unsigned* bar; unsigned x;
    volatile LAS unsigned* st;
};
__device__ __forceinline__ XcdBarrier xcd_barrier_post(unsigned* bar, volatile LAS unsigned* st) {
    XcdBarrier b; b.bar = bar; b.x = xb_xcc_id(); b.st = st;
    if (threadIdx.x == 0) (void)xb_add(&bar[XB_XCNT(b.x)], 1u);
    return b;
}
__device__ __forceinline__ void xcd_barrier_complete(unsigned* bar, unsigned x, unsigned& nloc, unsigned& nx) {
    const unsigned G = gridDim.x * gridDim.y * gridDim.z;
    unsigned sum, cnt, mine, sp = 0u;
    for (;;) {
        sum = 0u; cnt = 0u; mine = 0u;
#pragma unroll
        for (unsigned j = 0; j < 16; ++j) { const unsigned c = xb_ld(&bar[XB_XCNT(j)]); sum += c; cnt += (c > 0u) ? 1u : 0u; mine = (j == x) ? c : mine; }
        if (sum == G) break;
        __builtin_amdgcn_s_sleep(1);
        if ((++sp & 255u) == 0u) { if (xb_ld(&bar[XB_TMO])) break; if (sp > XB_SPIN_CAP) { atomicAdd(&bar[XB_TMO], 1u); break; } }
    }
    nloc = mine > 0u ? mine : 1u; nx = cnt > 0u ? cnt : 1u;
}
__device__ __forceinline__ void xcd_barrier(const XcdBarrier& b) {
    asm volatile("s_waitcnt vmcnt(0)" ::: "memory");
    __syncthreads();
    if (threadIdx.x == 0) {
        unsigned* bar = b.bar;
        __builtin_amdgcn_s_waitcnt(0);
        unsigned nloc = b.st[0], nx = b.st[1];
        if (nloc == 0u) { xcd_barrier_complete(bar, b.x, nloc, nx); b.st[0] = nloc; b.st[1] = nx; }
        const unsigned old = xb_add(&bar[XB_XSUB(b.x)], 1u);
        const unsigned gen = old / nloc;
        if (old + 1u == (gen + 1u) * nloc) {
            __builtin_amdgcn_fence(__ATOMIC_RELEASE, "agent");
            asm volatile("s_waitcnt vmcnt(0)" ::: "memory");
            const unsigned og = xb_add(&bar[XB_TOP], 1u);
            const unsigned tg = og / nx;
            if (og + 1u == (tg + 1u) * nx) xb_add(&bar[XB_TOPGEN], 1u);
            else XB_SPIN(xb_ld(&bar[XB_TOPGEN]) == tg, bar);
            __builtin_amdgcn_fence(__ATOMIC_ACQUIRE, "agent");
            xb_add(&bar[XB_XGEN(b.x)], 1u);
            asm volatile("s_waitcnt vmcnt(0)" ::: "memory");
        } else {
            XB_SPIN(xb_ld(&bar[XB_XGEN(b.x)]) == gen, bar);
            __builtin_amdgcn_fence(__ATOMIC_ACQUIRE, "agent");
            asm volatile("s_waitcnt vmcnt(0)" ::: "memory");
        }
    }
    __syncthreads();
}

constexpr int RING_BYTES = 131072;
constexpr int LDSCTL_OFF = 143360, MISC_OFF = LDSCTL_OFF + 320;
constexpr int LDS_BYTES = 147456;

constexpr int TR_SCR_BYTES = 64 * 65 * 4;
template <bool GAIN = false>
__device__ __forceinline__ void tr_item(const float* W, size_t ldw, int k0, int c0, bf16* WT, int nd0, int K, LAS float* scr, int lane, const float* gk = nullptr, int kd0 = -1) {
    if (kd0 < 0) kd0 = k0;
#pragma unroll
    for (int i = 0; i < 64; ++i) scr[i * 65 + lane] = __builtin_nontemporal_load(W + (size_t)(k0 + i) * ldw + c0 + lane);
    asm volatile("s_waitcnt lgkmcnt(0)" ::: "memory");
    const int c = lane & 7;
    f32x4 g0 = {1.f, 1.f, 1.f, 1.f}, g1 = g0;
    if (GAIN) { g0 = *(const f32x4*)(gk + k0 + 8 * c); g1 = *(const f32x4*)(gk + k0 + 8 * c + 4); }
#pragma unroll
    for (int j = 0; j < 8; ++j) { const int n = (lane >> 3) + 8 * j; const LAS float* s = scr + (8 * c) * 65 + n;
        u32x4 o; o.x = pk2(s[0 * 65] * g0.x, s[1 * 65] * g0.y); o.y = pk2(s[2 * 65] * g0.z, s[3 * 65] * g0.w); o.z = pk2(s[4 * 65] * g1.x, s[5 * 65] * g1.y); o.w = pk2(s[6 * 65] * g1.z, s[7 * 65] * g1.w);
        if (GAIN) __builtin_nontemporal_store(o, (u32x4*)(WT + blk(nd0 + n, kd0 + 8 * c, K))); else *(u32x4*)(WT + blk(nd0 + n, kd0 + 8 * c, K)) = o; }
    asm volatile("s_waitcnt lgkmcnt(0)" ::: "memory");
}
template <bool GAIN = false, bool NT = false>
__device__ __forceinline__ void tr_super(const float* W, size_t ldw, int k0, int c0, bf16* WT, int nd0, int K, LAS unsigned char* lds, int wave, int lane, int kd0, const float* gk = nullptr) {
    LAS float* tile = (LAS float*)lds;
#pragma unroll
    for (int r = 0; r < 8; ++r)
#pragma unroll
        for (int h = 0; h < 8; ++h) tile[(8 * wave + r) * 513 + 64 * h + lane] = __builtin_nontemporal_load(W + (size_t)(k0 + 8 * wave + r) * ldw + c0 + 64 * h + lane);
    __syncthreads();
    const int c = lane & 7;
    f32x4 g0 = {1.f, 1.f, 1.f, 1.f}, g1 = g0;
    if (GAIN) { g0 = *(const f32x4*)(gk + k0 + 8 * c); g1 = *(const f32x4*)(gk + k0 + 8 * c + 4); }
#pragma unroll
    for (int j = 0; j < 8; ++j) { const int n = (lane >> 3) + 8 * j; const LAS float* t = tile + (8 * c) * 513 + 64 * wave + n;
        u32x4 o; o.x = pk2(t[0 * 513] * g0.x, t[1 * 513] * g0.y); o.y = pk2(t[2 * 513] * g0.z, t[3 * 513] * g0.w); o.z = pk2(t[4 * 513] * g1.x, t[5 * 513] * g1.y); o.w = pk2(t[6 * 513] * g1.z, t[7 * 513] * g1.w);
        if (NT) __builtin_nontemporal_store(o, (u32x4*)(WT + blk(nd0 + 64 * wave + n, kd0 + 8 * c, K))); else *(u32x4*)(WT + blk(nd0 + 64 * wave + n, kd0 + 8 * c, K)) = o; }
    __syncthreads();
}
__device__ __forceinline__ void tr_plain(const float* W, int K, int N, size_t ldw, int coff, bf16* WT, LAS float* scr, int item, int lane) {
    const int nblk = N / 64, kb = item / nblk, nb = item % nblk;
    tr_item(W, ldw, 64 * kb, coff + 64 * nb, WT, 64 * nb, K, scr, lane);
}
template <bool GAIN = false>
__device__ __forceinline__ void tr_w13(const float* W, int which, bf16* WT, LAS float* scr, int item, int lane, const float* gk = nullptr) {
    const int nblk = FF / 64, kb = item / nblk, nb = item % nblk, n0 = 64 * nb;
    tr_item<GAIN>(W, FF, 64 * kb, n0, WT, (n0 >> 7) * 256 + which * 128 + (n0 & 127), D, scr, lane, gk);
}
__device__ __forceinline__ void gates_rows32(LAS unsigned char* lds, const bf16* XB, const bf16* WGB, const float* ssq, float* GT, int row0, int tid) {
    const int lane = tid & 63, wave = __builtin_amdgcn_readfirstlane(tid >> 6);
    f32x4 acc[2] = {{0.f, 0.f, 0.f, 0.f}, {0.f, 0.f, 0.f, 0.f}};
    const int kb = 512 * wave + 8 * (lane >> 4);
#pragma unroll 4
    for (int ks = 0; ks < 16; ++ks) {
        const bf16x8 bw = *(const bf16x8*)(WGB + (size_t)(lane & 15) * D + kb + 32 * ks);
#pragma unroll
        for (int rb = 0; rb < 2; ++rb) { const bf16x8 a = *(const bf16x8*)(XB + blk(row0 + 16 * rb + (lane & 15), kb + 32 * ks, D));
            acc[rb] = __builtin_amdgcn_mfma_f32_16x16x32_bf16(a, bw, acc[rb], 0, 0, 0); }
    }
    LAS float* red = (LAS float*)lds;
#pragma unroll
    for (int rb = 0; rb < 2; ++rb)
#pragma unroll
        for (int r = 0; r < 4; ++r) red[((wave * 2 + rb) * 4 + r) * 64 + lane] = acc[rb][r];
    __syncthreads();
    {
        const int row = tid >> 4, gate = tid & 15, rb = row >> 4, rr = row & 15, src = ((rr >> 2) << 4) + gate, reg = rr & 3;
        float s = 0.f;
#pragma unroll
        for (int w = 0; w < 8; ++w) s += red[((w * 2 + rb) * 4 + reg) * 64 + src];
        GT[(size_t)(row0 + row) * 16 + gate] = s / sqrtf(ssq[row0 + row] * (1.0f / D) + RMS_EPS);
    }
    __syncthreads();
}

template <int MODE>
__device__ __forceinline__ void norm_row(const float* xrow, const float* g, bf16* hrow, float* orow, const float* wgt, float* grow, int lane, int mrow = 0) {
    const f32x4* xr = (const f32x4*)xrow + lane; const f32x4* gr = (const f32x4*)g + lane;
    f32x4 v[16]; float s = 0.f;
#pragma unroll
    for (int j = 0; j < 16; ++j) { v[j] = __builtin_nontemporal_load(xr + 64 * j); s += (v[j].x * v[j].x + v[j].y * v[j].y) + (v[j].z * v[j].z + v[j].w * v[j].w); }
    const float rstd = 1.0f / sqrtf(wave_sum(s) * (1.0f / D) + RMS_EPS);
#pragma unroll
    for (int j = 0; j < 16; ++j) v[j] = v[j] * rstd * gr[64 * j];
    if (MODE == 2) {
#pragma unroll
        for (int j = 0; j < 16; ++j) ((f32x4*)orow + lane)[64 * j] = v[j];
    } else {
#pragma unroll
        for (int j = 0; j < 16; ++j) { u32x2 w; w.x = pk2(v[j].x, v[j].y); w.y = pk2(v[j].z, v[j].w); *(u32x2*)(hrow + blk(mrow, 4 * lane + 256 * j, D)) = w; }
    }
    if (MODE == 1) {
        float mine = 0.f;
#pragma unroll 1
        for (int c = 0; c < 16; ++c) { const f32x4* wr = (const f32x4*)(wgt + (size_t)c * D) + lane; float p = 0.f;
#pragma unroll
            for (int j = 0; j < 16; ++j) { const f32x4 w = wr[64 * j]; p += (v[j].x * w.x + v[j].y * w.y) + (v[j].z * w.z + v[j].w * w.w); }
            p = wave_sum(p); if (lane == c) mine = p; }
        if (lane < 16) grow[lane] = mine;
    }
}

__device__ __forceinline__ float logsigmoidf_acc(float x) { return fminf(x, 0.f) - log1pf(expf(-fabsf(x))); }

constexpr int KS_STRIDE = 272, VS_STRIDE = 528;
__device__ __forceinline__ void mlstm_passA(LAS unsigned char* lds, const bf16* P, const float* GT, const float* convw, const float* b_i, const float* b_f,
                                            bf16* QC, bf16* KC, float* UL, float* NL, float* SC, int unit, int tid) {
    const int lane = tid & 63, wave = __builtin_amdgcn_readfirstlane(tid >> 6);
    const int h = unit >> 7, c = unit & 127, t0 = c * CH;
    LAS unsigned char* KS = lds; LAS unsigned char* VS = lds + 64 * KS_STRIDE; LAS float* SRC = (LAS float*)(lds + 64 * KS_STRIDE + 64 * VS_STRIDE);
    if (wave == 0) {
        const int t = t0 + lane;
        const float li = GT[t * 16 + h] + b_i[h];
        float b = logsigmoidf_acc(GT[t * 16 + 8 + h] + b_f[h]);
#pragma unroll
        for (int o = 1; o < 64; o <<= 1) { const float y = __shfl_up(b, o); if (lane >= o) b += y; }
        const float blast = __shfl(b, 63);
        const float a = blast - b + li;
        const float amax = wave_max(a);
        SRC[lane] = expf(a - amax);
        if (lane == 0) { SC[(h * NCH + c) * 2] = blast; SC[(h * NCH + c) * 2 + 1] = amax; }
    }
#pragma unroll
    for (int i = 0; i < 4; ++i) { const int id = tid + 512 * i, s = id >> 5, cc = (id & 31) * 8;
        *(LAS u32x4*)(VS + s * VS_STRIDE + cc * 2) = *(const u32x4*)(P + (size_t)(t0 + s) * NP + PC_MV + h * DV + cc); }
    __syncthreads();
    {
        const int s = tid >> 3, cc = (tid & 7) * 16, t = t0 + s;
#pragma unroll
        for (int which = 0; which < 2; ++which) {
            const int pcol = which * 1024 + h * DK + cc;
            float a[16];
#pragma unroll
            for (int i = 0; i < 16; ++i) a[i] = 0.f;
#pragma unroll
            for (int j = 0; j < 4; ++j) { const int tt = t - 3 + j;
                if (tt >= 0) { const u32x4 x0 = *(const u32x4*)(P + (size_t)tt * NP + pcol), x1 = *(const u32x4*)(P + (size_t)tt * NP + pcol + 8);
                    const f32x4* w4 = (const f32x4*)(convw + j * 2048 + pcol); const f32x4 w0 = w4[0], w1 = w4[1], w2 = w4[2], w3 = w4[3];
                    a[0] += w0.x * bflo(x0.x); a[1] += w0.y * bfhi(x0.x); a[2] += w0.z * bflo(x0.y); a[3] += w0.w * bfhi(x0.y);
                    a[4] += w1.x * bflo(x0.z); a[5] += w1.y * bfhi(x0.z); a[6] += w1.z * bflo(x0.w); a[7] += w1.w * bfhi(x0.w);
                    a[8] += w2.x * bflo(x1.x); a[9] += w2.y * bfhi(x1.x); a[10] += w2.z * bflo(x1.y); a[11] += w2.w * bfhi(x1.y);
                    a[12] += w3.x * bflo(x1.z); a[13] += w3.y * bfhi(x1.z); a[14] += w3.z * bflo(x1.w); a[15] += w3.w * bfhi(x1.w); } }
            const float sc = which ? 0.08838834764831845f : 1.0f;
#pragma unroll
            for (int i = 0; i < 16; ++i) a[i] = fsilu(a[i]) * sc;
            bf16* dst = (which ? KC : QC) + (size_t)t * 1024 + h * DK + cc;
            u32x4 o0, o1; o0.x = pk2(a[0], a[1]); o0.y = pk2(a[2], a[3]); o0.z = pk2(a[4], a[5]); o0.w = pk2(a[6], a[7]);
            o1.x = pk2(a[8], a[9]); o1.y = pk2(a[10], a[11]); o1.z = pk2(a[12], a[13]); o1.w = pk2(a[14], a[15]);
            *(u32x4*)dst = o0; *(u32x4*)(dst + 8) = o1;
            if (which) { const float sr = SRC[s];
                o0.x = pk2(a[0] * sr, a[1] * sr); o0.y = pk2(a[2] * sr, a[3] * sr); o0.z = pk2(a[4] * sr, a[5] * sr); o0.w = pk2(a[6] * sr, a[7] * sr);
                o1.x = pk2(a[8] * sr, a[9] * sr); o1.y = pk2(a[10] * sr, a[11] * sr); o1.z = pk2(a[12] * sr, a[13] * sr); o1.w = pk2(a[14] * sr, a[15] * sr);
                *(LAS u32x4*)(KS + s * KS_STRIDE + cc * 2) = o0; *(LAS u32x4*)(KS + s * KS_STRIDE + cc * 2 + 16) = o1; }
        }
    }
    __syncthreads();
    {
        const int hh = lane >> 5, q4 = (lane & 15) >> 2, p4 = lane & 3, g2 = (lane >> 4) & 1;
        f32x16 acc[4];
#pragma unroll
        for (int jb = 0; jb < 4; ++jb)
#pragma unroll
            for (int r = 0; r < 16; ++r) acc[jb][r] = 0.f;
#pragma unroll
        for (int ks = 0; ks < 4; ++ks) { const int rlo = 16 * ks + 8 * hh + q4, rhi = rlo + 4;
            const int vcol = (32 * wave + 16 * g2 + 4 * p4) * 2;
            const bf16x8 af = cat8(ds_tr(VS + rlo * VS_STRIDE + vcol), ds_tr(VS + rhi * VS_STRIDE + vcol));
#pragma unroll
            for (int jb = 0; jb < 4; ++jb) { const int kcol = (32 * jb + 16 * g2 + 4 * p4) * 2;
                const bf16x8 bfr = cat8(ds_tr(KS + rlo * KS_STRIDE + kcol), ds_tr(KS + rhi * KS_STRIDE + kcol));
                acc[jb] = MFMA32(bfr, af, acc[jb]); } }
        bf16* ul = (bf16*)UL + (size_t)unit * (DV * DK) + (size_t)(32 * wave + (lane & 31)) * DK;
#pragma unroll
        for (int jb = 0; jb < 4; ++jb)
#pragma unroll
            for (int gq = 0; gq < 4; ++gq) { u32x2 w; w.x = pk2(acc[jb][4 * gq], acc[jb][4 * gq + 1]); w.y = pk2(acc[jb][4 * gq + 2], acc[jb][4 * gq + 3]);
                *(u32x2*)(ul + 32 * jb + 8 * gq + 4 * hh) = w; }
    }
    if (tid < DK) { float sn = 0.f;
#pragma unroll 8
        for (int s = 0; s < CH; ++s) sn += bf2f(*(LAS const unsigned short*)(KS + s * KS_STRIDE + tid * 2));
        NL[(size_t)unit * DK + tid] = sn; }
    __syncthreads();
}

__device__ __forceinline__ void mlstm_passB(const float* UL, const float* NL, const float* SC, bf16* CST, float* NS, float* MS, int gtid, int nthreads) {
    for (int p = gtid; p < MLH * DV * DK / 2; p += nthreads) {
        const int h = p >> 14, e = (p & 16383) * 2;
        float m = 0.f, c0 = 0.f, c1 = 0.f;
        for (int cb = 0; cb < NCH; cb += 8) {
            f32x2 u[8];
#pragma unroll
            for (int j = 0; j < 8; ++j) u[j] = *(const f32x2*)(UL + (size_t)(h * NCH + cb + j) * (DV * DK) + e);
#pragma unroll
            for (int j = 0; j < 8; ++j) { const int c = cb + j; const float bl = SC[(h * NCH + c) * 2], am = SC[(h * NCH + c) * 2 + 1];
                *(unsigned*)(CST + (size_t)(h * NCH + c) * (DV * DK) + e) = pk2(c0, c1);
                if ((p & 16383) == 0) MS[h * NCH + c] = m;
                const float mn = fmaxf(bl + m, am), al = expf(bl + m - mn), be = expf(am - mn);
                c0 = al * c0 + be * u[j].x; c1 = al * c1 + be * u[j].y; m = mn; }
        }
    }
    for (int p = gtid; p < MLH * DK; p += nthreads) {
        const int h = p >> 7, dk = p & 127; float m = 0.f, n = 0.f;
        for (int c = 0; c < NCH; ++c) { const float bl = SC[(h * NCH + c) * 2], am = SC[(h * NCH + c) * 2 + 1];
            NS[(size_t)(h * NCH + c) * DK + dk] = n;
            const float mn = fmaxf(bl + m, am), al = expf(bl + m - mn), be = expf(am - mn);
            n = al * n + be * NL[(size_t)(h * NCH + c) * DK + dk]; m = mn; }
    }
}

__device__ __forceinline__ void scan_table(const float* SC, int h, LAS f32x2* tab, float* ms, int lane) {
    const f32x2 s0 = *(const f32x2*)(SC + (size_t)(h * NCH + lane) * 2), s1 = *(const f32x2*)(SC + (size_t)(h * NCH + 64 + lane) * 2);
    float i0 = s0.x, i1 = s1.x;
#pragma unroll
    for (int o = 1; o < 64; o <<= 1) { const float y0 = __shfl_up(i0, o), y1 = __shfl_up(i1, o); if (lane >= o) { i0 += y0; i1 += y1; } }
    i1 += __shfl(i0, 63);
    const float g0 = s0.y - i0, g1 = s1.y - i1;
    float p0 = g0, p1 = g1;
#pragma unroll
    for (int o = 1; o < 64; o <<= 1) { const float y0 = __shfl_up(p0, o), y1 = __shfl_up(p1, o); if (lane >= o) { p0 = fmaxf(p0, y0); p1 = fmaxf(p1, y1); } }
    const float e0 = __shfl_up(p0, 1), e1 = __shfl_up(p1, 1), top0 = fmaxf(__shfl(p0, 63), 0.f);
    const float t0 = lane ? fmaxf(e0, 0.f) : 0.f, t1 = lane ? fmaxf(e1, top0) : top0;
    const float m0 = (i0 - s0.x) + t0, m1 = (i1 - s1.x) + t1;
    const float n0 = i0 + fmaxf(t0, g0), n1 = i1 + fmaxf(t1, g1);
    tab[lane] = (f32x2){expf(s0.x + m0 - n0), expf(s0.y - n0)};
    tab[lane + 64] = (f32x2){expf(s1.x + m1 - n1), expf(s1.y - n1)};
    if (ms) { ms[h * NCH + lane] = m0; ms[h * NCH + 64 + lane] = m1; }
}
#ifndef MK_SCAN_BATCH
#define MK_SCAN_BATCH 16
#endif
constexpr int SCAN_BATCH = MK_SCAN_BATCH;
template <int V4>
__device__ __forceinline__ void mlstm_passBv(const float* UL, const float* NL, const float* SC, bf16* CST, float* NS, float* MS, int t, int nthreads, LAS f32x2* tabw, int lane) {
    constexpr int EPT = 4 * V4, PER_HEAD = DV * DK / EPT;
    for (int p = t; p < MLH * PER_HEAD; p += nthreads) {
        const int h = __builtin_amdgcn_readfirstlane(p / PER_HEAD), e = (p % PER_HEAD) * EPT;
        scan_table(SC, h, tabw, ((p - lane) % PER_HEAD) == 0 ? MS : nullptr, lane);
        f32x4 cc[V4];
#pragma unroll
        for (int v = 0; v < V4; ++v) cc[v] = (f32x4){0.f, 0.f, 0.f, 0.f};
        for (int cb = 0; cb < NCH; cb += SCAN_BATCH) {
            f32x4 u[SCAN_BATCH][V4];
#pragma unroll
            for (int j = 0; j < SCAN_BATCH; ++j)
#pragma unroll
                for (int v = 0; v < V4; ++v) { const u32x2 w = *(const u32x2*)((const bf16*)UL + (size_t)(h * NCH + cb + j) * (DV * DK) + e + 4 * v); u[j][v] = (f32x4){bflo(w.x), bfhi(w.x), bflo(w.y), bfhi(w.y)}; }
#pragma unroll
            for (int j = 0; j < SCAN_BATCH; ++j) { const int c = cb + j; const f32x2 ab = tabw[c];
#pragma unroll
                for (int v = 0; v < V4; ++v) { u32x2 w; w.x = pk2(cc[v][0], cc[v][1]); w.y = pk2(cc[v][2], cc[v][3]); *(u32x2*)(CST + (size_t)(h * NCH + c) * (DV * DK) + e + 4 * v) = w; }
#pragma unroll
                for (int v = 0; v < V4; ++v) cc[v] = cc[v] * ab.x + u[j][v] * ab.y; }
        }
    }
    for (int p = t; p < MLH * DK; p += nthreads) {
        const int h = __builtin_amdgcn_readfirstlane(p >> 7), dk = p & 127; float n = 0.f;
        scan_table(SC, h, tabw, nullptr, lane);
        for (int cb = 0; cb < NCH; cb += SCAN_BATCH) {
            float u[SCAN_BATCH];
#pragma unroll
            for (int j = 0; j < SCAN_BATCH; ++j) u[j] = NL[(size_t)(h * NCH + cb + j) * DK + dk];
#pragma unroll
            for (int j = 0; j < SCAN_BATCH; ++j) { const int c = cb + j; const f32x2 ab = tabw[c]; NS[(size_t)(h * NCH + c) * DK + dk] = n; n = ab.x * n + ab.y * u[j]; }
        }
    }
}

__device__ __forceinline__ void mlstm_passB8(const float* UL, const float* NL, const float* SC, bf16* CST, float* NS, float* MS, int t, int nthreads, LAS f32x2* tabw, int lane) {
    constexpr int PER_HEAD = DV * DK / 2;
    for (int p = t; p < MLH * PER_HEAD; p += nthreads) {
        const int h = __builtin_amdgcn_readfirstlane(p / PER_HEAD), e = (p % PER_HEAD) * 2;
        scan_table(SC, h, tabw, ((p - lane) % PER_HEAD) == 0 ? MS : nullptr, lane);
        f32x2 cc = {0.f, 0.f};
        for (int cb = 0; cb < NCH; cb += SCAN_BATCH) {
            unsigned u[SCAN_BATCH];
#pragma unroll
            for (int j = 0; j < SCAN_BATCH; ++j) u[j] = *(const unsigned*)((const bf16*)UL + (size_t)(h * NCH + cb + j) * (DV * DK) + e);
#pragma unroll
            for (int j = 0; j < SCAN_BATCH; ++j) { const int c = cb + j; const f32x2 ab = tabw[c];
                *(unsigned*)(CST + (size_t)(h * NCH + c) * (DV * DK) + e) = pk2(cc.x, cc.y);
                cc = cc * ab.x + (f32x2){bflo(u[j]), bfhi(u[j])} * ab.y; }
        }
    }
    for (int p = t; p < MLH * DK; p += nthreads) {
        const int h = __builtin_amdgcn_readfirstlane(p >> 7), dk = p & 127; float n = 0.f;
        scan_table(SC, h, tabw, nullptr, lane);
        for (int cb = 0; cb < NCH; cb += SCAN_BATCH) {
            float u[SCAN_BATCH];
#pragma unroll
            for (int j = 0; j < SCAN_BATCH; ++j) u[j] = NL[(size_t)(h * NCH + cb + j) * DK + dk];
#pragma unroll
            for (int j = 0; j < SCAN_BATCH; ++j) { const int c = cb + j; const f32x2 ab = tabw[c]; NS[(size_t)(h * NCH + c) * DK + dk] = n; n = ab.x * n + ab.y * u[j]; }
        }
    }
}

__device__ __forceinline__ void mlstm_passC(LAS unsigned char* lds, const bf16* P, const float* GT, const float* b_i, const float* b_f, const bf16* QC, const bf16* KC,
                                            const bf16* CST, const float* NS, const float* MS, const float* gout, bf16* YA, int unit, int tid) {
    const int lane = tid & 63, wave = __builtin_amdgcn_readfirstlane(tid >> 6);
    const int h = unit >> 7, c = unit & 127, t0 = c * CH;
    LAS unsigned char* QS = lds; LAS unsigned char* KS = lds + 64 * KS_STRIDE; LAS unsigned char* VS = lds + 128 * KS_STRIDE;
    LAS float* FB = (LAS float*)(lds + 128 * KS_STRIDE + 64 * VS_STRIDE);
    LAS float* GV = FB; LAS float* CM = FB + 64; LAS float* DEC = FB + 128; LAS float* ENM = FB + 192; LAS float* SSQ = FB + 256; LAS float* NSS = FB + 512;
    if (wave == 0) {
        const int t = t0 + lane;
        const float li = GT[t * 16 + h] + b_i[h];
        float b = logsigmoidf_acc(GT[t * 16 + 8 + h] + b_f[h]);
#pragma unroll
        for (int o = 1; o < 64; o <<= 1) { const float y = __shfl_up(b, o); if (lane >= o) b += y; }
        const float g = li - b; float cm = g;
#pragma unroll
        for (int o = 1; o < 64; o <<= 1) { const float y = __shfl_up(cm, o); if (lane >= o) cm = fmaxf(cm, y); }
        const float mprev = MS[h * NCH + c];
        cm = fmaxf(cm, mprev);
        GV[lane] = g; CM[lane] = cm; DEC[lane] = expf(mprev - cm); ENM[lane] = expf(-(b + cm));
    } else if (wave == 1 || wave == 2) { const int dk = tid - 64; NSS[dk] = NS[(size_t)unit * DK + dk]; }
#pragma unroll
    for (int i = 0; i < 2; ++i) { const int id = tid + 512 * i, s = id >> 4, cc = (id & 15) * 8; const size_t go = (size_t)(t0 + s) * 1024 + h * DK + cc;
        *(LAS u32x4*)(QS + s * KS_STRIDE + cc * 2) = *(const u32x4*)(QC + go); *(LAS u32x4*)(KS + s * KS_STRIDE + cc * 2) = *(const u32x4*)(KC + go); }
#pragma unroll
    for (int i = 0; i < 4; ++i) { const int id = tid + 512 * i, s = id >> 5, cc = (id & 31) * 8;
        *(LAS u32x4*)(VS + s * VS_STRIDE + cc * 2) = *(const u32x4*)(P + (size_t)(t0 + s) * NP + PC_MV + h * DV + cc); }
    const int tb = wave & 1, dvq = wave >> 1, tl = 32 * tb + (lane & 31), hh = lane >> 5, q4 = (lane & 15) >> 2, p4 = lane & 3, g2 = (lane >> 4) & 1;
    bf16x8 cfr[2][8];
    {   const bf16* cst = CST + (size_t)unit * (DV * DK);
#pragma unroll
        for (int db = 0; db < 2; ++db)
#pragma unroll
            for (int ks = 0; ks < 8; ++ks) cfr[db][ks] = *(const bf16x8*)(cst + (size_t)(64 * dvq + 32 * db + (lane & 31)) * DK + 16 * ks + 8 * hh); }
    __builtin_amdgcn_sched_barrier(0);
    __syncthreads();
    bf16x8 qf[8];
#pragma unroll
    for (int ks = 0; ks < 8; ++ks) qf[ks] = *(LAS const bf16x8*)(QS + tl * KS_STRIDE + (16 * ks + 8 * hh) * 2);
    const float cmt = CM[tl], dect = DEC[tl];
    bf16x8 wf[2][2]; float dsum = 0.f;
#pragma unroll
    for (int sb = 0; sb < 2; ++sb) {
        if (sb <= tb) {
            f32x16 st;
#pragma unroll
            for (int r = 0; r < 16; ++r) st[r] = 0.f;
#pragma unroll
            for (int ks = 0; ks < 8; ++ks) { const bf16x8 kf = *(LAS const bf16x8*)(KS + (32 * sb + (lane & 31)) * KS_STRIDE + (16 * ks + 8 * hh) * 2); st = MFMA32(kf, qf[ks], st); }
            float w[16];
#pragma unroll
            for (int r = 0; r < 16; ++r) { const int s = 32 * sb + crow(r, hh); const float e = __expf(GV[s] - cmt); w[r] = (s <= tl) ? st[r] * e : 0.f; dsum += w[r]; }
            wf[sb][0] = pack8(w[0], w[1], w[2], w[3], w[4], w[5], w[6], w[7]);
            wf[sb][1] = pack8(w[8], w[9], w[10], w[11], w[12], w[13], w[14], w[15]);
        } else { wf[sb][0] = (bf16x8){0, 0, 0, 0, 0, 0, 0, 0}; wf[sb][1] = wf[sb][0]; }
    }
    f32x16 acc[2];
#pragma unroll
    for (int db = 0; db < 2; ++db) {
#pragma unroll
        for (int r = 0; r < 16; ++r) acc[db][r] = 0.f;
#pragma unroll
        for (int ks = 0; ks < 8; ++ks) acc[db] = MFMA32(cfr[db][ks], qf[ks], acc[db]);
#pragma unroll
        for (int r = 0; r < 16; ++r) acc[db][r] *= dect;
#pragma unroll
        for (int sb = 0; sb < 2; ++sb) {
            if (sb <= tb) {
#pragma unroll
                for (int sp = 0; sp < 2; ++sp) { const int rlo = 32 * sb + 16 * sp + 4 * hh + q4, rhi = rlo + 8; const int vcol = (64 * dvq + 32 * db + 16 * g2 + 4 * p4) * 2;
                    const bf16x8 vf = cat8(ds_tr(VS + rlo * VS_STRIDE + vcol), ds_tr(VS + rhi * VS_STRIDE + vcol));
                    acc[db] = MFMA32(vf, wf[sb][sp], acc[db]); }
            }
        }
    }
    float qn = 0.f;
#pragma unroll
    for (int j = 0; j < 8; ++j) { const u32x4 qv = *(LAS const u32x4*)(QS + tl * KS_STRIDE + (64 * hh + 8 * j) * 2); const LAS float* nn = NSS + 64 * hh + 8 * j;
        qn += bflo(qv.x) * nn[0] + bfhi(qv.x) * nn[1] + bflo(qv.y) * nn[2] + bfhi(qv.y) * nn[3] + bflo(qv.z) * nn[4] + bfhi(qv.z) * nn[5] + bflo(qv.w) * nn[6] + bfhi(qv.w) * nn[7]; }
    qn += __shfl_xor(qn, 32); dsum += __shfl_xor(dsum, 32);
    const float den = dect * qn + dsum, inv = 1.0f / fmaxf(fabsf(den), ENM[tl]);
    float ss = 0.f;
#pragma unroll
    for (int db = 0; db < 2; ++db)
#pragma unroll
        for (int r = 0; r < 16; ++r) { acc[db][r] *= inv; ss += acc[db][r] * acc[db][r]; }
    ss += __shfl_xor(ss, 32);
    if (hh == 0) SSQ[tl * 4 + dvq] = ss;
    f32x4 gg[2][4]; u32x2 og[2][4];
#pragma unroll
    for (int db = 0; db < 2; ++db)
#pragma unroll
        for (int gq = 0; gq < 4; ++gq) { const int dv0 = 64 * dvq + 32 * db + 8 * gq + 4 * hh;
            gg[db][gq] = *(const f32x4*)(gout + h * DV + dv0); og[db][gq] = *(const u32x2*)(P + (size_t)(t0 + tl) * NP + PC_MO + h * DV + dv0); }
    __syncthreads();
    const float rstd = 1.0f / sqrtf(((SSQ[tl * 4] + SSQ[tl * 4 + 1]) + (SSQ[tl * 4 + 2] + SSQ[tl * 4 + 3])) * (1.0f / DV) + RMS_EPS);
#pragma unroll
    for (int db = 0; db < 2; ++db)
#pragma unroll
        for (int gq = 0; gq < 4; ++gq) { const int dv0 = 64 * dvq + 32 * db + 8 * gq + 4 * hh; const f32x4 g4 = gg[db][gq]; const u32x2 o2 = og[db][gq];
            u32x2 o; o.x = pk2(acc[db][4 * gq] * rstd * g4.x * bflo(o2.x), acc[db][4 * gq + 1] * rstd * g4.y * bfhi(o2.x));
            o.y = pk2(acc[db][4 * gq + 2] * rstd * g4.z * bflo(o2.y), acc[db][4 * gq + 3] * rstd * g4.w * bfhi(o2.y));
            *(u32x2*)(YA + blk(t0 + tl, h * DV + dv0, D)) = o; }
    __syncthreads();
}

__device__ __forceinline__ void sb_unit(LAS unsigned char* vs, const bf16* P, bf16* YB, int hd, int qb, int lane) {
    const int tl = lane & 31, hh = lane >> 5, q4 = (lane & 15) >> 2, p4 = lane & 3, g2 = (lane >> 4) & 1;
    const int t = 32 * qb + tl;
    bf16x8 qf[8];
#pragma unroll
    for (int ks = 0; ks < 8; ++ks) qf[ks] = *(const bf16x8*)(P + (size_t)t * NP + PC_SQ + hd * HD + 16 * ks + 8 * hh);
    f32x16 o[4];
#pragma unroll
    for (int cb = 0; cb < 4; ++cb)
#pragma unroll
        for (int r = 0; r < 16; ++r) o[cb][r] = 0.f;
    float R = 1.f;
    const bf16* kbase = P + (size_t)tl * NP + PC_SK + hd * HD + 8 * hh;
    const bf16* vbase = P + (size_t)(lane >> 4) * NP + PC_SV + hd * HD + (lane & 15) * 8;
    bf16x8 kf[8];
#pragma unroll
    for (int ks = 0; ks < 8; ++ks) kf[ks] = *(const bf16x8*)(kbase + (size_t)(32 * qb) * NP + 16 * ks);
    for (int kt = qb; kt >= 0; --kt) {
        const int s0 = 32 * kt, sn = kt > 0 ? s0 - 32 : s0;
        bf16x8 kn[8]; u32x4 vr[8];
#pragma unroll
        for (int i = 0; i < 8; ++i) vr[i] = *(const u32x4*)(vbase + (size_t)(s0 + 4 * i) * NP);
#pragma unroll
        for (int ks = 0; ks < 8; ++ks) kn[ks] = *(const bf16x8*)(kbase + (size_t)sn * NP + 16 * ks);
        f32x16 z;
#pragma unroll
        for (int r = 0; r < 16; ++r) z[r] = 0.f;
#pragma unroll
        for (int ks = 0; ks < 8; ++ks) z = MFMA32(kf[ks], qf[ks], z);
        float om[16], be[16];
        if (kt == qb) {
#pragma unroll
            for (int r = 0; r < 16; ++r) { const float ex = __builtin_amdgcn_exp2f(fminf(z[r] * 1.44269504f, 80.f)); const float w = __builtin_amdgcn_rcpf(1.0f + ex);
                const bool valid = (s0 + crow(r, hh)) < t; om[r] = valid ? w : 1.f; be[r] = valid ? ex * w : 0.f; }
        } else {
#pragma unroll
            for (int r = 0; r < 16; ++r) { const float ex = __builtin_amdgcn_exp2f(fminf(z[r] * 1.44269504f, 80.f)); const float w = __builtin_amdgcn_rcpf(1.0f + ex); om[r] = w; be[r] = ex * w; }
        }
        float e[16], tot[4], otot[4];
#pragma unroll
        for (int g = 0; g < 4; ++g) { e[4 * g + 3] = 1.f; e[4 * g + 2] = om[4 * g + 3]; e[4 * g + 1] = e[4 * g + 2] * om[4 * g + 2]; e[4 * g] = e[4 * g + 1] * om[4 * g + 1]; tot[g] = e[4 * g] * om[4 * g]; }
#pragma unroll
        for (int g = 0; g < 4; ++g) otot[g] = __shfl_xor(tot[g], 32);
        float so[4], xe[4], base[4];
        so[3] = 1.f; so[2] = tot[3]; so[1] = so[2] * tot[2]; so[0] = so[1] * tot[1];
        xe[3] = 1.f; xe[2] = otot[3]; xe[1] = xe[2] * otot[2]; xe[0] = xe[1] * otot[1];
#pragma unroll
        for (int g = 0; g < 4; ++g) base[g] = R * so[g] * (hh == 0 ? xe[g] * otot[g] : xe[g]);
        const float total = (so[0] * tot[0]) * (xe[0] * otot[0]);
        float p[16];
#pragma unroll
        for (int r = 0; r < 16; ++r) p[r] = be[r] * ((r & 3) == 3 ? base[r >> 2] : base[r >> 2] * e[r]);
        const bf16x8 pf0 = pack8(p[0], p[1], p[2], p[3], p[4], p[5], p[6], p[7]), pf1 = pack8(p[8], p[9], p[10], p[11], p[12], p[13], p[14], p[15]);
#pragma unroll
        for (int i = 0; i < 8; ++i) *(LAS u32x4*)(vs + (4 * i + (lane >> 4)) * KS_STRIDE + (lane & 15) * 16) = vr[i];
        bf16x8 vf[4][2];
#pragma unroll
        for (int cb = 0; cb < 4; ++cb)
#pragma unroll
            for (int sp = 0; sp < 2; ++sp) { const int rlo = 16 * sp + 4 * hh + q4, rhi = rlo + 8; const int vcol = (32 * cb + 16 * g2 + 4 * p4) * 2;
                vf[cb][sp] = cat8(ds_tr(vs + rlo * KS_STRIDE + vcol), ds_tr(vs + rhi * KS_STRIDE + vcol)); }
#pragma unroll
        for (int sp = 0; sp < 2; ++sp)
#pragma unroll
            for (int cb = 0; cb < 4; ++cb) o[cb] = MFMA32(vf[cb][sp], sp ? pf1 : pf0, o[cb]);
        R *= total;
        if (__all(R == 0.f)) break;
#pragma unroll
        for (int ks = 0; ks < 8; ++ks) kf[ks] = kn[ks];
    }
#pragma unroll
    for (int cb = 0; cb < 4; ++cb)
#pragma unroll
        for (int gq = 0; gq < 4; ++gq) { u32x2 w; w.x = pk2(o[cb][4 * gq], o[cb][4 * gq + 1]); w.y = pk2(o[cb][4 * gq + 2], o[cb][4 * gq + 3]);
            *(u32x2*)(YB + blk(t, 2048 + hd * HD + 32 * cb + 8 * gq + 4 * hh, D)) = w; }
}

#ifndef MK_N_LAUNCHES
#define MK_N_LAUNCHES 1
#endif
#ifndef PG_ALIGN
#define PG_ALIGN true
#endif
#ifndef PG_SP2
#define PG_SP2 true
#endif
#ifndef MK_REP5A
#define MK_REP5A 1
#endif
#ifndef MK_REP5S
#define MK_REP5S 1
#endif
#ifndef MK_SIDE_BY_SIDE
#define MK_SIDE_BY_SIDE 1
#endif
#ifndef MK_SCAN_WAVES
#define MK_SCAN_WAVES 4
#endif
constexpr int N_PHASES = 14;
#ifndef MK_REPS
#define MK_REPS {1,1,1,1,1,1,1,1,1,1,1,1,1,1}
#endif
constexpr int REP[N_PHASES] = MK_REPS;
struct Args { const float* in[19]; float* out; unsigned char* ws; int ph_lo, ph_hi; };

constexpr int CW_CVQ = 8192;
__device__ __forceinline__ void cv_tail_w2(const float* W, bf16* WT, unsigned* head, LAS unsigned char* lds, int wave, int lane) {
    constexpr int N = (FF / 64) * 8;
    volatile LAS unsigned* slot = (volatile LAS unsigned*)(lds + 139264);
    for (;;) {
        if (wave == 0 && lane == 0) *slot = __hip_atomic_fetch_add(head, 1u, __ATOMIC_RELAXED, __HIP_MEMORY_SCOPE_AGENT);
        __syncthreads();
        const unsigned o = (unsigned)__builtin_amdgcn_readfirstlane((int)*slot);
        if (o >= (unsigned)N) break;
        tr_super(W, D, 64 * (int)(o >> 3), 512 * (int)(o & 7), WT, 512 * (int)(o & 7), FF, lds, wave, lane, 64 * (int)(o >> 3));
    }
}

__global__ void __launch_bounds__(NTHR, 2) mk_fwd(Args args) {
    extern __shared__ __attribute__((aligned(16))) unsigned char lds_raw[];
    LAS unsigned char* lds = (LAS unsigned char*)lds_raw;
    const int tid = threadIdx.x, lane = tid & 63, wave = __builtin_amdgcn_readfirstlane(tid >> 6);
    const int G = gridDim.x, bx = blockIdx.x;
    for (int u = tid; u < (LDS_BYTES - LDSCTL_OFF) / 4; u += NTHR) ((LAS unsigned*)(lds + LDSCTL_OFF))[u] = 0u;
    __syncthreads();
    unsigned char* ws = args.ws;
    unsigned* ctl = (unsigned*)(ws + WS_CTL);
    const int lo = args.ph_lo, hi = args.ph_hi;
    XcdBarrier bar; bar.bar = ctl + CW_BAR; bar.x = 0; bar.st = nullptr;
    if (hi - lo > 1) bar = xcd_barrier_post(ctl + CW_BAR, (volatile LAS unsigned*)(lds + MISC_OFF) + 8);
#define IN(k) (lo <= (k) && (k) < hi)
#define SEAM(k) do { if (IN(k) && IN((k) + 1)) xcd_barrier(bar); } while (0)
#define REPEAT(k) for (int rep = 0; rep < REP[k]; ++rep)
#define RSEAM(k) do { if (rep + 1 < REP[k]) xcd_barrier(bar); } while (0)

    const float* x = args.in[0];
    bf16* W13_1 = (bf16*)(ws + WS_W13_1); bf16* W2_1 = (bf16*)(ws + WS_W2_1); bf16* W13_2 = (bf16*)(ws + WS_W13_2); bf16* W2_2 = (bf16*)(ws + WS_W2_2);
    bf16* WIN = (bf16*)(ws + WS_WIN); bf16* WPA = (bf16*)(ws + WS_WPA); bf16* WPB = (bf16*)(ws + WS_WPB); bf16* WOUT = (bf16*)(ws + WS_WOUT);
    bf16* H = (bf16*)(ws + WS_H); bf16* U = (bf16*)(ws + WS_U); float* X1 = (float*)(ws + WS_X1); bf16* P = (bf16*)(ws + WS_P);
    bf16* YA = (bf16*)(ws + WS_YA); bf16* YB = YA;     bf16* MG = (bf16*)(ws + WS_H); float* TT = (float*)(ws + WS_U);
    float* UL = (float*)(ws + WS_U); bf16* CST = (bf16*)(ws + WS_H);
    float* GT = (float*)(ws + WS_GATE); float* WG = (float*)(ws + WS_WG); float* SC = (float*)(ws + WS_SC); float* MS = (float*)(ws + WS_MS);
    float* SSQ = (float*)(ws + WS_CTL + CTL_SSQ); bf16* XB = (bf16*)(ws + WS_XB); bf16* XB2 = (bf16*)(ws + WS_XB2); float* X3 = (float*)(ws + WS_X3); bf16* WGB = (bf16*)(ws + WS_WG);
    float* NL = (float*)(ws + WS_NL); float* NS = (float*)(ws + WS_NS); bf16* QC = (bf16*)(ws + WS_QC); bf16* KC = (bf16*)(ws + WS_KC);
    const int gw = bx * NWAVES + wave, NGW = G * NWAVES;

    if (IN(0)) REPEAT(0) {
        LAS float* scr = (LAS float*)(lds + wave * TR_SCR_BYTES);
        constexpr int I13 = (D / 64) * (FF / 64), I2 = (FF / 64) * (D / 64), IIN = (D / 64) * (NP / 64), IPA = (2048 / 64) * (D / 64), IO = (D / 64) * (D / 64);
        constexpr int NITEMS = 4 * I13;
        for (int o = bx; o < 1024; o += G) {
            if (o < 256) tr_super<false, true>(args.in[11], D, 64 * (o >> 3), 512 * (o & 7), WPA, 512 * (o & 7), D, lds, wave, lane, 64 * (o >> 3));
            else if (o < 512) tr_super<false, true>(args.in[12], D, 64 * ((o - 256) >> 3), 512 * (o & 7), WPA, 512 * (o & 7), D, lds, wave, lane, 2048 + 64 * ((o - 256) >> 3));
            else tr_super<false, true>(args.in[13], D, 64 * ((o - 512) >> 3), 512 * (o & 7), WOUT, 512 * (o & 7), D, lds, wave, lane, 64 * ((o - 512) >> 3));
        }
        for (int o = bx; o < (D / 64) * (NP / 512); o += G) { const int kb = o / (NP / 512), n0 = 512 * (o % (NP / 512));
            tr_super<true, true>(args.in[6], DIN, 64 * kb, n0 + (n0 >= PC_SQ ? 16 : 0), WIN, n0, D, lds, wave, lane, 64 * kb, args.in[5]); }
        for (int it = gw; it < NITEMS; it += NGW) {
            int r = it;
            if (r < I13) { tr_w13<true>(args.in[15], 0, W13_2, scr, r, lane, args.in[14]); continue; } r -= I13;
            if (r < I13) { tr_w13<true>(args.in[16], 1, W13_2, scr, r, lane, args.in[14]); continue; } r -= I13;
            if (r < I13) { tr_w13(args.in[2], 0, W13_1, scr, r, lane); continue; } r -= I13;
            tr_w13(args.in[3], 1, W13_1, scr, r, lane);
        }
        for (int i = bx * NTHR + tid; i < 16 * D; i += G * NTHR) { const int c = i >> 12, k = i & (D - 1); const unsigned w = pk2(args.in[6][(size_t)k * DIN + 6144 + c] * args.in[5][k], 0.f); WGB[i] = (bf16)(w & 0xffffu); }
        for (int m = gw; m < M; m += NGW) norm_row<0>(x + (size_t)m * D, args.in[1], H, nullptr, nullptr, nullptr, lane, m);
        RSEAM(0);
    }
    SEAM(0);
    if (IN(1)) REPEAT(1) {
        pg8::Gemm g{H, W13_1, M, 2 * FF, D}; pg8::StaticOrder S; S.init(M, 2 * FF, G, bx);
        pg8::EpiSwiGLU E{U, FF, nullptr};
        pg8::gemm_phase<pg8::EpiSwiGLU, pg8::StaticOrder, PG_ALIGN, PG_SP2>(lds, g, S, E);
        __syncthreads();
        cv_tail_w2(args.in[4], W2_1, ctl + CW_CVQ, lds, wave, lane);
        RSEAM(1);
    }
    SEAM(1);
    if (IN(2)) REPEAT(2) {
        pg8::Gemm g{U, W2_1, M, D, FF}; pg8::StaticOrder S; S.init(M, D, G, bx);
        pg8::EpiResidX<0> E{x, nullptr, nullptr, 0.5f, XB, SSQ};
        pg8::gemm_phase<pg8::EpiResidX<0>, pg8::StaticOrder, PG_ALIGN, PG_SP2>(lds, g, S, E);
        RSEAM(2);
    }
    SEAM(2);
    if (IN(4)) REPEAT(4) {
        for (int r0 = 32 * bx; r0 < M; r0 += 32 * G) gates_rows32(lds, XB, WGB, SSQ, GT, r0, tid);
        pg8::Gemm g{XB, WIN, M, NP, D}; pg8::StaticOrder S; S.init(M, NP, G, bx);
        pg8::EpiP E{P, NP, SSQ};
        pg8::gemm_phase<pg8::EpiP, pg8::StaticOrder, PG_ALIGN, PG_SP2>(lds, g, S, E);
        RSEAM(4);
    }
    SEAM(4);
    if (IN(5)) REPEAT(5) {
#if MK_SIDE_BY_SIDE == 3
        for (int v = gw * 2; v < SBH * (M / 32); v += NGW * 2)
#pragma unroll 1
            for (int k = 0; k < 2; ++k) { const int u = v + k; sb_unit(lds + wave * (32 * KS_STRIDE), P, YB, (u >> 1) & 15, ((u >> 5) << 1) | (u & 1), lane); }
        __syncthreads();
#endif
        for (int ra = 0; ra < MK_REP5A; ++ra)
        for (int u = bx; u < MLH * NCH; u += G) mlstm_passA(lds, P, GT, args.in[7], args.in[8], args.in[9], QC, KC, UL, NL, SC, u, tid);
#if !MK_SIDE_BY_SIDE
        for (int rs = 0; rs < MK_REP5S; ++rs)
        for (int u = gw; u < SBH * (M / 32); u += NGW) sb_unit(lds + wave * (32 * KS_STRIDE), P, YB, u & 15, u >> 4, lane);
#endif
        RSEAM(5);
    }
    SEAM(5);
#if MK_SIDE_BY_SIDE == 2
    if (IN(6)) REPEAT(6) {
        mlstm_passB8(UL, NL, SC, CST, NS, MS, bx * NTHR + tid, G * NTHR, (LAS f32x2*)(lds + 8 * 32 * KS_STRIDE + wave * 1024), lane);
        for (int v = gw * 2; v < SBH * (M / 32); v += NGW * 2)
#pragma unroll 1
            for (int k = 0; k < 2; ++k) { const int u = v + k; sb_unit(lds + wave * (32 * KS_STRIDE), P, YB, (u >> 1) & 15, ((u >> 5) << 1) | (u & 1), lane); }
        RSEAM(6);
    }
#elif MK_SIDE_BY_SIDE == 3 || MK_SIDE_BY_SIDE == 4
    if (IN(6)) REPEAT(6) { mlstm_passB8(UL, NL, SC, CST, NS, MS, bx * NTHR + tid, G * NTHR, (LAS f32x2*)(lds + wave * 1024), lane); RSEAM(6); }
#elif MK_SIDE_BY_SIDE
    if (IN(6)) REPEAT(6) {
        constexpr int NBW = MK_SCAN_WAVES, NAW = NWAVES - NBW;
        if (wave < NBW) mlstm_passBv<4 / NBW>(UL, NL, SC, CST, NS, MS, bx * (64 * NBW) + tid, G * (64 * NBW), (LAS f32x2*)(lds + 65536 + wave * 1024), lane);
        else {
            for (int v = (bx * NAW + (wave - NBW)) * 4; v < SBH * (M / 32); v += G * NAW * 4)
#pragma unroll 1
                for (int k = 0; k < 4; ++k) { const int u = v + k; sb_unit(lds + (wave - NBW) * (32 * KS_STRIDE), P, YB, (u >> 2) & 15, ((u >> 6) << 2) | (u & 3), lane); }
        }
        RSEAM(6);
    }
#else
    if (IN(6)) REPEAT(6) { mlstm_passB8(UL, NL, SC, CST, NS, MS, bx * NTHR + tid, G * NTHR, (LAS f32x2*)(lds + wave * 1024), lane); RSEAM(6); }
#endif
    SEAM(6);
    if (IN(7)) REPEAT(7) {
        for (int u = bx; u < MLH * NCH; u += G) mlstm_passC(lds, P, GT, args.in[8], args.in[9], QC, KC, CST, NS, MS, args.in[10], YA, u, tid);
#if MK_SIDE_BY_SIDE == 4
        for (int v = gw * 2; v < SBH * (M / 32); v += NGW * 2)
#pragma unroll 1
            for (int k = 0; k < 2; ++k) { const int u = v + k; sb_unit(lds + wave * (32 * KS_STRIDE), P, YB, (u >> 1) & 15, ((u >> 5) << 1) | (u & 1), lane); }
#endif
        RSEAM(7);
    }
    SEAM(7);
#define P8_BODY() do { \
        pg8::Gemm g{YA, WPA, M, D, D}; pg8::StaticOrder S; S.init(M, D, G, bx); pg8::EpiProjAB E{P, MG}; \
        pg8::gemm_phase<pg8::EpiProjAB, pg8::StaticOrder, PG_ALIGN, PG_SP2>(lds, g, S, E); } while (0)
    if (IN(8)) {
        P8_BODY();
#if defined(MK_DUP8)
        xcd_barrier(bar); P8_BODY(); xcd_barrier(bar); P8_BODY();
#endif
    }
    SEAM(8);
    if (IN(9)) REPEAT(9) {
        pg8::Gemm g{MG, WOUT, M, D, D}; pg8::StaticOrder S; S.init(M, D, G, bx);
        pg8::EpiResidX<1> E{nullptr, XB, nullptr, 1.0f, XB2, SSQ + M};
        pg8::gemm_phase<pg8::EpiResidX<1>, pg8::StaticOrder, PG_ALIGN, PG_SP2>(lds, g, S, E);
        RSEAM(9);
    }
    SEAM(9);
    if (IN(11)) REPEAT(11) {
        pg8::Gemm g{XB2, W13_2, M, 2 * FF, D}; pg8::StaticOrder S; S.init(M, 2 * FF, G, bx);
        pg8::EpiSwiGLU E{U, FF, SSQ + M};
        pg8::gemm_phase<pg8::EpiSwiGLU, pg8::StaticOrder, PG_ALIGN, PG_SP2>(lds, g, S, E);
        __syncthreads();
        cv_tail_w2(args.in[17], W2_2, ctl + CW_CVQ + 64, lds, wave, lane);
        RSEAM(11);
    }
    SEAM(11);
    if (IN(12)) REPEAT(12) {
        pg8::Gemm g{U, W2_2, M, D, FF}; pg8::StaticOrder S; S.init(M, D, G, bx);
        pg8::EpiResidX<2> E{nullptr, XB2, X3, 0.5f, nullptr, nullptr};
        pg8::gemm_phase<pg8::EpiResidX<2>, pg8::StaticOrder, PG_ALIGN, PG_SP2>(lds, g, S, E);
        RSEAM(12);
    }
    SEAM(12);
    if (IN(13)) REPEAT(13) {
        for (int m = gw; m < M; m += NGW) norm_row<2>(X3 + (size_t)m * D, args.in[18], nullptr, args.out + (size_t)m * D, nullptr, nullptr, lane);
    }
#if defined(MK_EXTRA_PH)
    if (IN(14)) { if (wave < 4) mlstm_passBv<1>(UL, NL, SC, CST, NS, MS, bx * 256 + tid, G * 256, (LAS f32x2*)(lds + 65536 + wave * 1024), lane); }
    if (IN(15)) { if (wave >= 4) for (int v = (bx * 4 + (wave - 4)) * 4; v < SBH * (M / 32); v += G * 16)
        for (int k = 0; k < 4; ++k) { const int u = v + k; sb_unit(lds + (wave - 4) * (32 * KS_STRIDE), P, YB, (u >> 2) & 15, ((u >> 6) << 2) | (u & 3), lane); } }
#endif
#undef IN
#undef SEAM
}

extern "C" void kernel_launch(void* const* d_in, const int* in_sizes, int n_in, void* d_out, int out_size, void* d_ws, size_t ws_size, hipStream_t stream) {
    static int grid = 0;
    if (grid == 0) {
        if (n_in != 19 || in_sizes[0] != M * D || out_size != M * D || ws_size < WS_END) {
            fprintf(stderr, "kernel_launch: unexpected shapes (n_in %d, in0 %d, out %d, ws %zu < %zu); nothing launched\n", n_in, n_in > 0 ? in_sizes[0] : -1, out_size, ws_size, (size_t)WS_END); grid = -1; return; }
        int dev = 0, cus = 0, per_cu = 0;
        if (hipGetDevice(&dev) != hipSuccess || hipDeviceGetAttribute(&cus, hipDeviceAttributeMultiprocessorCount, dev) != hipSuccess) { grid = -1; return; }
        if (hipFuncSetAttribute((const void*)mk_fwd, hipFuncAttributeMaxDynamicSharedMemorySize, LDS_BYTES) != hipSuccess) { fprintf(stderr, "kernel_launch: hipFuncSetAttribute failed\n"); grid = -1; return; }
        if (hipOccupancyMaxActiveBlocksPerMultiprocessor(&per_cu, (const void*)mk_fwd, NTHR, LDS_BYTES) != hipSuccess || per_cu < 1)
            fprintf(stderr, "kernel_launch: note: occupancy query reports %d workgroups per CU\n", per_cu);
        (void)hipGetLastError();
        grid = cus;
    }
    if (grid < 0) return;
    if (hipMemsetAsync((char*)d_ws + WS_CTL, 0, CTL_ZERO_BYTES, stream) != hipSuccess) { fprintf(stderr, "kernel_launch: memset failed\n"); return; }
    Args a{};
    for (int i = 0; i < 19; ++i) a.in[i] = (const float*)d_in[i];
    a.out = (float*)d_out; a.ws = (unsigned char*)d_ws;
#if defined(MK_EXTRA_PH)
#define MK_EXTRA_AFTER 1
#endif
#if MK_N_LAUNCHES == 1
    a.ph_lo = 0; a.ph_hi = N_PHASES;
    hipLaunchKernelGGL(mk_fwd, dim3(grid), dim3(NTHR), LDS_BYTES, stream, a);
#else
    for (int k = 0; k < N_PHASES; ++k) { a.ph_lo = k; a.ph_hi = k + 1; hipLaunchKernelGGL(mk_fwd, dim3(grid), dim3(NTHR), LDS_BYTES, stream, a); }
#endif
#if defined(MK_EXTRA_AFTER)
    for (int k = 0; k < MK_EXTRA_N; ++k) { a.ph_lo = MK_EXTRA_PH; a.ph_hi = MK_EXTRA_PH + 1; hipLaunchKernelGGL(mk_fwd, dim3(grid), dim3(NTHR), LDS_BYTES, stream, a); }
#endif
    const hipError_t le = hipPeekAtLastError();
    if (le != hipSuccess) fprintf(stderr, "kernel_launch: launch failed: %s\n", hipGetErrorName(le));
}
```
